# Optimizing an MI355X kernel written in HIP

```python
import math, functools
import jax, jax.numpy as jnp
from jax import lax
import numpy as np

D_MODEL = 1024
BATCH = 32
SEQ = 256
DEPTH = 2
DEC_BATCH = 8
DEC_SEQ = 4096
PAST_LEN = 512

GRID_W = 64
FNET_WIDTH = D_MODEL // 2
FNET_GROUP = 128
FNET_GROUPS = FNET_WIDTH // FNET_GROUP
NA_WIDTH = D_MODEL // 2
NA_HEADS = 8
HEAD_DIM = NA_WIDTH // NA_HEADS
WIN_ROWS_MAX = 8
WIN_COLS = 16
EVEN_IN_WIDTH = 2 * FNET_WIDTH + 4 * NA_WIDTH
HYENA_WIDTH = D_MODEL
HYENA_ORDER = 2
POS_EMB_DIM = 33
FILTER_HIDDEN = 64
SHORT_CONV = 3
DECAY_TARGET = 1e-2
FAST_DECAY_PCT = 0.3
SLOW_DECAY_PCT = 1.5
MAX_DECAY = math.log(DECAY_TARGET) / FAST_DECAY_PCT
MIN_DECAY = math.log(DECAY_TARGET) / SLOW_DECAY_PCT
EPS = 1e-6

kernel_name = "hybrid_fnet_natten_hyena_prefix_step"


def rms_norm(x, g):
    xf = x.astype(jnp.float32)
    y = xf * lax.rsqrt(jnp.mean(xf * xf, axis=-1, keepdims=True) + EPS)
    return (y * g.astype(jnp.float32)).astype(x.dtype)


def ada_mod(cond, w, b):
    m = jax.nn.silu(cond) @ w + b
    return jnp.split(m, 3, axis=-1)


def fourier_mix(u):
    b_, l_, _ = u.shape
    ug = u.astype(jnp.float32).reshape(b_, l_, FNET_GROUPS, FNET_GROUP).transpose(0, 2, 1, 3)
    f = jnp.fft.fft2(ug, norm="ortho").real
    return f.transpose(0, 2, 1, 3).reshape(b_, l_, FNET_WIDTH).astype(u.dtype)


def context_attention(q, k, v):
    s = jnp.einsum('bqhd,bkhd->bhqk', q, k).astype(jnp.float32) * (q.shape[-1] ** -0.5)
    p = jax.nn.softmax(s, axis=-1).astype(v.dtype)
    return jnp.einsum('bhqk,bkhd->bqhd', p, v)


def neighbourhood_attention(q, k, v, k_ctx, v_ctx, rel_bias):
    b_, l_, h_, dh = q.shape
    rows = l_ // GRID_W
    wr = min(WIN_ROWS_MAX, rows)
    band = wr * GRID_W
    sc = dh ** -0.5
    cols = jnp.arange(GRID_W)
    col_start = jnp.clip(cols - WIN_COLS // 2, 0, GRID_W - WIN_COLS)
    col_ok = (cols[None, :] >= col_start[:, None]) & (cols[None, :] < col_start[:, None] + WIN_COLS)
    dc_idx = jnp.clip(cols[None, :] - cols[:, None], -(WIN_COLS - 1), WIN_COLS - 1) + WIN_COLS - 1
    q_rows = jnp.arange(rows)
    row_start = jnp.clip(q_rows - wr // 2, 0, rows - wr)
    q_blk = q.reshape(b_, rows, GRID_W, h_, dh).swapaxes(0, 1)

    def row_block(args):
        r, start, qb = args
        kb = lax.dynamic_slice_in_dim(k, start * GRID_W, band, axis=1)
        vb = lax.dynamic_slice_in_dim(v, start * GRID_W, band, axis=1)
        dr_idx = start + jnp.arange(wr) - r + WIN_ROWS_MAX - 1
        bias = rel_bias[:, dr_idx[None, :, None], dc_idx[:, None, :]]
        s_loc = jnp.einsum('bqhd,bkhd->bhqk', qb, kb).astype(jnp.float32).reshape(b_, h_, GRID_W, wr, GRID_W)
        s_loc = s_loc * sc + bias.astype(jnp.float32)
        s_loc = jnp.where(col_ok[:, None, :], s_loc, -jnp.inf).reshape(b_, h_, GRID_W, band)
        s_ctx = jnp.einsum('bqhd,bphd->bhqp', qb, k_ctx).astype(jnp.float32) * sc
        p = jax.nn.softmax(jnp.concatenate([s_loc, s_ctx], axis=-1), axis=-1).astype(v.dtype)
        return (jnp.einsum('bhqk,bkhd->bqhd', p[..., :band], vb)
                + jnp.einsum('bhqp,bphd->bqhd', p[..., band:], v_ctx))

    out = lax.map(row_block, (q_rows, row_start, q_blk))
    return out.swapaxes(0, 1).reshape(b_, l_, h_, dh)


def even_layer(x, cond, norm_g, mod_w, mod_b, in_w, qn_g, kn_g, out_w, attend):
    shift, scale, gate = ada_mod(cond, mod_w, mod_b)
    h = rms_norm(x, norm_g) * (1 + scale) + shift
    b_, l_, _ = x.shape
    splits = list(np.cumsum([FNET_WIDTH, FNET_WIDTH, NA_WIDTH, NA_WIDTH, NA_WIDTH]))
    a_val, a_gate, q, k, v, b_gate = jnp.split(h @ in_w, splits, axis=-1)
    q = rms_norm(q.reshape(b_, l_, NA_HEADS, HEAD_DIM), qn_g)
    k = rms_norm(k.reshape(b_, l_, NA_HEADS, HEAD_DIM), kn_g)
    v = v.reshape(b_, l_, NA_HEADS, HEAD_DIM)
    a = fourier_mix(a_val) * jax.nn.silu(a_gate)
    bo = attend(q, k, v).reshape(b_, l_, NA_WIDTH) * jax.nn.silu(b_gate)
    y = jnp.concatenate([a, bo], axis=-1) @ out_w
    return x + gate * y, k, v


def short_conv(u, w, b):
    l_ = u.shape[1]
    pad = SHORT_CONV // 2
    up = jnp.pad(u, ((0, 0), (pad, pad), (0, 0)))
    return sum(up[:, j:j + l_] * w[j] for j in range(SHORT_CONV)) + b


def hyena_filters(l_, w1, b1, fr1, w2, b2, fr2, w3):
    t = jnp.linspace(0.0, 1.0, l_, dtype=jnp.float32)[:, None]
    bands = (POS_EMB_DIM - 1) // 2
    w = 2.0 * math.pi * jnp.arange(l_, dtype=jnp.float32)[:, None] / l_
    f = jnp.linspace(1e-4, bands - 1, bands, dtype=jnp.float32)[None, :]
    z = jnp.concatenate([t, jnp.cos(f * w), -jnp.sin(f * w)], axis=-1)
    hid = jnp.sin(fr1 * (z @ w1 + b1))
    hid = jnp.sin(fr2 * (hid @ w2 + b2))
    h = (hid @ w3).astype(jnp.float32).reshape(l_, 2, HYENA_ORDER, HYENA_WIDTH)
    deltas = jnp.abs(jnp.linspace(MIN_DECAY, MAX_DECAY, HYENA_WIDTH, dtype=jnp.float32))
    h = h * jnp.exp(-t * deltas)[:, None, None, :]
    h = h / (jnp.sum(jnp.abs(h), axis=(0, 1), keepdims=True) + EPS)
    h = h.transpose(1, 2, 0, 3)
    return h[0], h[1]


def long_conv(u, h_f, h_b, skip):
    l_ = u.shape[1]
    g = jnp.concatenate([h_f, jnp.zeros_like(h_f[:1]), h_b[:0:-1]], axis=0)
    uf = jnp.fft.rfft(u.astype(jnp.float32), n=2 * l_, axis=1)
    gf = jnp.fft.rfft(g, n=2 * l_, axis=0)
    y = jnp.fft.irfft(uf * gf[None], n=2 * l_, axis=1)[:, :l_]
    return (y + u.astype(jnp.float32) * skip.astype(jnp.float32)).astype(u.dtype)


def odd_layer(x, cond, norm_g, mod_w, mod_b, in_w, sconv_w, sconv_b,
              fw1, fb1, ffr1, fw2, fb2, ffr2, fw3, fskip, out_w):
    shift, scale, gate = ada_mod(cond, mod_w, mod_b)
    h = rms_norm(x, norm_g) * (1 + scale) + shift
    proj = h @ in_w
    n_conv = (HYENA_ORDER + 1) * HYENA_WIDTH
    u = short_conv(proj[..., :n_conv], sconv_w, sconv_b)
    g_path = proj[..., n_conv:]
    parts = jnp.split(u, HYENA_ORDER + 1, axis=-1)
    h_f, h_b = hyena_filters(x.shape[1], fw1, fb1, ffr1, fw2, fb2, ffr2, fw3)
    z = parts[0]
    for n in range(HYENA_ORDER):
        z = parts[n + 1] * long_conv(z, h_f[n], h_b[n], fskip[n])
    y = (z * jax.nn.silu(g_path)) @ out_w
    return x + gate * y


def setup_inputs(seed: int = 0) -> dict:
    key = jax.random.key(seed)
    ks = jax.random.split(key, 32)
    nrm = lambda k, shape, s: jax.random.normal(k, shape, jnp.float32) * s
    d = D_MODEL
    hw = HYENA_WIDTH
    return {
        "x_prompt": nrm(ks[0], (BATCH, SEQ, d), 1.0),
        "x_sample": nrm(ks[1], (DEC_BATCH, DEC_SEQ, d), 1.0),
        "cache_k0": nrm(ks[2], (DEC_BATCH, PAST_LEN, NA_HEADS, HEAD_DIM), 1.0),
        "cache_v0": nrm(ks[3], (DEC_BATCH, PAST_LEN, NA_HEADS, HEAD_DIM), 1.0),
        "c": nrm(ks[4], (DEC_BATCH, d), 1.0),
        "c_ctx": nrm(ks[5], (d,), 1.0),
        "norm0_g": 1.0 + nrm(ks[6], (d,), 0.02),
        "mod0_w": nrm(ks[7], (d, 3 * d), 0.5 * d ** -0.5),
        "mod0_b": nrm(ks[8], (3 * d,), 0.01),
        "in0_w": nrm(ks[9], (d, EVEN_IN_WIDTH), d ** -0.5),
        "q_norm_g": 1.0 + nrm(ks[10], (HEAD_DIM,), 0.02),
        "k_norm_g": 1.0 + nrm(ks[11], (HEAD_DIM,), 0.02),
        "na_rel_bias": nrm(ks[12], (NA_HEADS, 2 * WIN_ROWS_MAX - 1, 2 * WIN_COLS - 1), 0.1),
        "out0_w": nrm(ks[13], (FNET_WIDTH + NA_WIDTH, d), (FNET_WIDTH + NA_WIDTH) ** -0.5),
        "norm1_g": 1.0 + nrm(ks[14], (d,), 0.02),
        "mod1_w": nrm(ks[15], (d, 3 * d), 0.5 * d ** -0.5),
        "mod1_b": nrm(ks[16], (3 * d,), 0.01),
        "in1_w": nrm(ks[17], (d, (HYENA_ORDER + 2) * hw), d ** -0.5),
        "sconv1_w": nrm(ks[18], (SHORT_CONV, (HYENA_ORDER + 1) * hw), SHORT_CONV ** -0.5),
        "sconv1_b": nrm(ks[19], ((HYENA_ORDER + 1) * hw,), 0.01),
        "filt_w1": nrm(ks[20], (POS_EMB_DIM, FILTER_HIDDEN), POS_EMB_DIM ** -0.5),
        "filt_b1": nrm(ks[21], (FILTER_HIDDEN,), 0.1),
        "filt_freq1": 1.0 + nrm(ks[22], (FILTER_HIDDEN,), 0.05),
        "filt_w2": nrm(ks[23], (FILTER_HIDDEN, FILTER_HIDDEN), FILTER_HIDDEN ** -0.5),
        "filt_b2": nrm(ks[24], (FILTER_HIDDEN,), 0.1),
        "filt_freq2": 1.0 + nrm(ks[25], (FILTER_HIDDEN,), 0.05),
        "filt_w3": nrm(ks[26], (FILTER_HIDDEN, 2 * HYENA_ORDER * hw), FILTER_HIDDEN ** -0.5),
        "filt_skip": nrm(ks[27], (HYENA_ORDER, hw), 0.1),
        "out1_w": nrm(ks[28], (hw, d), hw ** -0.5),
    }


def reference(x_prompt, x_sample, cache_k0, cache_v0, c, c_ctx,
              norm0_g, mod0_w, mod0_b, in0_w, q_norm_g, k_norm_g, na_rel_bias, out0_w,
              norm1_g, mod1_w, mod1_b, in1_w, sconv1_w, sconv1_b,
              filt_w1, filt_b1, filt_freq1, filt_w2, filt_b2, filt_freq2, filt_w3, filt_skip, out1_w):
    cond_ctx = c_ctx[None, None, :]
    cond_lat = c[:, None, :]
    even = (norm0_g, mod0_w, mod0_b, in0_w, q_norm_g, k_norm_g, out0_w)
    odd = (norm1_g, mod1_w, mod1_b, in1_w, sconv1_w, sconv1_b,
           filt_w1, filt_b1, filt_freq1, filt_w2, filt_b2, filt_freq2, filt_w3, filt_skip, out1_w)
    layer_params = (even, odd)
    caches = ((cache_k0, cache_v0),)
    xp, xs = x_prompt, x_sample
    new_state = []
    for i in range(DEPTH):
        p = layer_params[i]
        if i % 2 == 0:
            ck, cv = caches[i // 2]
            xp, k_ctx, v_ctx = even_layer(xp, cond_ctx, *p, attend=context_attention)
            lat_attend = functools.partial(neighbourhood_attention, k_ctx=ck, v_ctx=cv, rel_bias=na_rel_bias)
            xs, _, _ = even_layer(xs, cond_lat, *p, attend=lat_attend)
            new_state.append(k_ctx)
            new_state.append(v_ctx)
        else:
            xp = odd_layer(xp, cond_ctx, *p)
            xs = odd_layer(xs, cond_lat, *p)
    new_k0, new_v0 = new_state
    return (xp, xs, new_k0, new_v0)
```

```cpp
#include <hip/hip_runtime.h>
#include <hip/hip_cooperative_groups.h>
#include <cstdio>
namespace cg = cooperative_groups;

#ifndef DUP_MASK
#define DUP_MASK 0
#endif
#ifndef SINGLE_LAUNCH
#define SINGLE_LAUNCH 1
#endif

#define DI __device__ __forceinline__
#define HD __device__ __forceinline__
#define SINCOSPI(x, s, c) do { *(s) = __builtin_amdgcn_sinf(0.5f * (x)); *(c) = __builtin_amdgcn_cosf(0.5f * (x)); } while (0)
#define OPAQUE(x) asm volatile("" : "+v"(x))
#ifdef DIAG_NOINLINE
#define ITEMFN __device__ __attribute__((noinline))
#else
#define ITEMFN __device__ __forceinline__
#endif

struct cpx { float x, y; };
HD cpx cmul(cpx a, cpx b) { cpx r; r.x = a.x * b.x - a.y * b.y; r.y = a.x * b.y + a.y * b.x; return r; }
HD cpx cmulc(cpx a, cpx b) { cpx r; r.x = a.x * b.x + a.y * b.y; r.y = a.y * b.x - a.x * b.y; return r; }
HD cpx cadd(cpx a, cpx b) { cpx r; r.x = a.x + b.x; r.y = a.y + b.y; return r; }
HD cpx csub(cpx a, cpx b) { cpx r; r.x = a.x - b.x; r.y = a.y - b.y; return r; }
template <bool INV> HD cpx mulmi(cpx a) { cpx r; if (!INV) { r.x = a.y; r.y = -a.x; } else { r.x = -a.y; r.y = a.x; } return r; }
template <bool INV> HD void dft4(cpx& a0, cpx& a1, cpx& a2, cpx& a3) {
  cpx s02 = cadd(a0, a2), d02 = csub(a0, a2), s13 = cadd(a1, a3), d13 = mulmi<INV>(csub(a1, a3));
  a0 = cadd(s02, s13); a2 = csub(s02, s13); a1 = cadd(d02, d13); a3 = csub(d02, d13);
}
template <bool INV> HD cpx twc(cpx a, float c, float s) {
  cpx r; if (!INV) { r.x = a.x * c + a.y * s; r.y = a.y * c - a.x * s; } else { r.x = a.x * c - a.y * s; r.y = a.y * c + a.x * s; } return r;
}
template <bool INV> HD void dft16(cpx (&v)[16]) {
#pragma unroll
  for (int b = 0; b < 4; ++b) dft4<INV>(v[b], v[4 + b], v[8 + b], v[12 + b]);
  const float C1 = 0.92387953251128674f, S1 = 0.38268343236508977f, R2 = 0.70710678118654752f;
  v[4 * 1 + 1] = twc<INV>(v[4 * 1 + 1], C1, S1);
  v[4 * 2 + 1] = twc<INV>(v[4 * 2 + 1], R2, R2);
  v[4 * 3 + 1] = twc<INV>(v[4 * 3 + 1], S1, C1);
  v[4 * 1 + 2] = twc<INV>(v[4 * 1 + 2], R2, R2);
  v[4 * 2 + 2] = mulmi<INV>(v[4 * 2 + 2]);
  v[4 * 3 + 2] = twc<INV>(v[4 * 3 + 2], -R2, R2);
  v[4 * 1 + 3] = twc<INV>(v[4 * 1 + 3], S1, C1);
  v[4 * 2 + 3] = twc<INV>(v[4 * 2 + 3], -R2, R2);
  v[4 * 3 + 3] = twc<INV>(v[4 * 3 + 3], -C1, -S1);
#pragma unroll
  for (int c = 0; c < 4; ++c) dft4<INV>(v[4 * c + 0], v[4 * c + 1], v[4 * c + 2], v[4 * c + 3]);
#pragma unroll
  for (int c = 0; c < 4; ++c)
#pragma unroll
    for (int d = c + 1; d < 4; ++d) { cpx t = v[4 * c + d]; v[4 * c + d] = v[4 * d + c]; v[4 * d + c] = t; }
}
HD int PADI(int p) { return p + (p >> 4); }
template <bool INV> HD void twiddle16(cpx (&v)[16], float c1, float s1) {
  cpx w[16];
  w[1].x = c1; w[1].y = INV ? s1 : -s1;
  w[2] = cmul(w[1], w[1]); w[3] = cmul(w[2], w[1]); w[4] = cmul(w[2], w[2]);
  w[5] = cmul(w[4], w[1]); w[6] = cmul(w[4], w[2]); w[7] = cmul(w[4], w[3]); w[8] = cmul(w[4], w[4]);
#pragma unroll
  for (int k = 9; k < 16; ++k) w[k] = cmul(w[8], w[k - 8]);
#pragma unroll
  for (int k = 1; k < 16; ++k) v[k] = cmul(v[k], w[k]);
}
template <int S, bool LOAD, bool STORE> HD void fft_fwd_pass(cpx (&v)[16], cpx* buf, int tid) {
  OPAQUE(tid);
  const int n1 = tid & (S - 1), hi = tid / S, base = hi * 16 * S + n1;
  cpx* bp = buf + PADI(base);
  constexpr int STR = S == 1 ? 1 : S + S / 16;
  if (LOAD) {
#pragma unroll
    for (int j = 0; j < 16; ++j) v[j] = bp[STR * j];
  }
  dft16<false>(v);
  if (S > 1) { int n1o = n1; OPAQUE(n1o); float s, c; SINCOSPI(2.0f * (float)n1o / (float)(16 * S), &s, &c); twiddle16<false>(v, c, s); }
  if (STORE) {
#pragma unroll
    for (int j = 0; j < 16; ++j) bp[STR * j] = v[j];
  }
}
template <int S, bool LOAD, bool STORE> HD void fft_inv_pass(cpx (&v)[16], cpx* buf, int tid) {
  OPAQUE(tid);
  const int n1 = tid & (S - 1), hi = tid / S, base = hi * 16 * S + n1;
  cpx* bp = buf + PADI(base);
  constexpr int STR = S == 1 ? 1 : S + S / 16;
  if (LOAD) {
#pragma unroll
    for (int j = 0; j < 16; ++j) v[j] = bp[STR * j];
  }
  if (S > 1) { int n1o = n1; OPAQUE(n1o); float s, c; SINCOSPI(2.0f * (float)n1o / (float)(16 * S), &s, &c); twiddle16<true>(v, c, s); }
  dft16<true>(v);
  if (STORE) {
#pragma unroll
    for (int j = 0; j < 16; ++j) bp[STR * j] = v[j];
  }
}


typedef unsigned short bfr;
using bf16x8 = __attribute__((ext_vector_type(8))) short;
using s16x4 = __attribute__((ext_vector_type(4))) short;
using f32x16 = __attribute__((ext_vector_type(16))) float;
using u32x4 = __attribute__((ext_vector_type(4))) unsigned;
using u32x2 = __attribute__((ext_vector_type(2))) unsigned;
using f32x4 = __attribute__((ext_vector_type(4))) float;
#define SB() __builtin_amdgcn_sched_barrier(0)
#define MFMA(a, b, c) __builtin_amdgcn_mfma_f32_32x32x16_bf16((a), (b), (c), 0, 0, 0)

constexpr int MT = 40960;
constexpr int MP = 8192;
constexpr int NPH = 11;

enum { I_XP = 0, I_XS, I_CK, I_CV, I_C, I_CCTX, I_NORM0G, I_MOD0W, I_MOD0B, I_IN0W, I_QNG, I_KNG, I_RELB, I_OUT0W,
       I_NORM1G, I_MOD1W, I_MOD1B, I_IN1W, I_SCW, I_SCB, I_FW1, I_FB1, I_FFR1, I_FW2, I_FB2, I_FFR2, I_FW3, I_FSKIP, I_OUT1W };

struct Params {
  const float* in[29];
  float* out;
  char* ws;
};

constexpr size_t OFF_W0T = 0;
constexpr size_t OFF_WO0T = 7340032;
constexpr size_t OFF_W1T = 9437184;
constexpr size_t OFF_WO1T = 17825792;
constexpr size_t OFF_MOD = 19922944;
constexpr size_t OFF_CKB = 20144128;
constexpr size_t OFF_CVT = 24338432;
constexpr size_t OFF_HID = 28532736;
constexpr size_t OFF_FSUM = 29646848;
constexpr size_t OFF_F256 = 29663232;
constexpr size_t OFF_F4096 = 33857536;
constexpr size_t OFF_R2 = 100966400;
constexpr size_t OFF_BIG = 184852480;
constexpr size_t OFF_R1 = OFF_BIG;
constexpr size_t OFF_AGT = OFF_BIG + 83886080;
constexpr size_t OFF_Q = OFF_BIG + 125829120;
constexpr size_t OFF_K = OFF_BIG + 167772160;
constexpr size_t OFF_VT = OFF_BIG + 209715200;
constexpr size_t OFF_BGT = OFF_BIG + 251658240;
constexpr size_t OFF_BAR = OFF_BIG + 335544320;
constexpr size_t WS_NEEDED = OFF_BAR + 16384;

constexpr size_t OUT_K = 41943040;
constexpr size_t OUT_V = 46137344;

DI int mytid() { int t = __builtin_amdgcn_workitem_id_x(); OPAQUE(t); return t; }
typedef __bf16 bf16x2_t __attribute__((ext_vector_type(2)));
DI bfr f2bf(float x) { __bf16 v = (__bf16)x; return __builtin_bit_cast(bfr, v); }
DI float bf2f(bfr b) { return __uint_as_float(((unsigned)b) << 16); }
DI unsigned pk2(float a, float b) { bf16x2_t v = {(__bf16)a, (__bf16)b}; return __builtin_bit_cast(unsigned, v); }
DI float siluf(float v) { return v / (1.f + __expf(-v)); }
DI int crow(int i, int h) { return (i & 3) + 8 * (i >> 2) + 4 * h; }
DI int clampi(int v, int lo, int hi) { return v < lo ? lo : (v > hi ? hi : v); }

ITEMFN void p0_mod(const Params& p, char* smem, int item) {
  const int tid = mytid();
  const int layer = item / 96, nb = item % 96;
  float* sl = (float*)smem;
  float* red = sl;
  const float* c = p.in[I_C];
  const float* cc = p.in[I_CCTX];
  for (int idx = tid; idx < 9 * 1024; idx += 256) {
    int ci = idx >> 10, k = idx & 1023;
    float v = ci < 8 ? c[ci * 1024 + k] : cc[k];
    sl[idx] = v / (1.f + expf(-v));
  }
  __syncthreads();
  const float* W = (layer ? p.in[I_MOD1W] : p.in[I_MOD0W]);
  const float* B = (layer ? p.in[I_MOD1B] : p.in[I_MOD0B]);
  const int kg = tid >> 5, col = tid & 31, n = nb * 32 + col;
  float acc[9];
#pragma unroll
  for (int ci = 0; ci < 9; ++ci) acc[ci] = 0.f;
#pragma unroll 4
  for (int k = kg * 128; k < kg * 128 + 128; ++k) {
    float w = W[(size_t)k * 3072 + n];
#pragma unroll
    for (int ci = 0; ci < 9; ++ci) acc[ci] += sl[ci * 1024 + k] * w;
  }
  __syncthreads();
#pragma unroll
  for (int ci = 0; ci < 9; ++ci) red[(kg * 9 + ci) * 32 + col] = acc[ci];
  __syncthreads();
  float* mod = (float*)(p.ws + OFF_MOD) + layer * 9 * 3072;
  for (int idx = tid; idx < 288; idx += 256) {
    int ci = idx >> 5, cl = idx & 31;
    float s = 0.f;
    for (int k2 = 0; k2 < 8; ++k2) s += red[(k2 * 9 + ci) * 32 + cl];
    mod[ci * 3072 + nb * 32 + cl] = s + B[nb * 32 + cl];
  }
  __syncthreads();
}

ITEMFN void p0_fold(const Params& p, char* smem, int item) {
  const int tid = mytid();
  const int g = item >> 5, k0 = (item & 31) * 32;
  float* a = (float*)smem;
  float* ct = a + 32 * 128;
  float* st = ct + 128;
  const float* W = p.in[I_IN0W];
  for (int idx = tid; idx < 32 * 128; idx += 256) {
    int kk = idx >> 7, cc = idx & 127;
    a[idx] = W[(size_t)(k0 + kk) * 3072 + g * 128 + cc];
  }
  if (tid < 128) { float s, c; sincospif(2.f * (float)tid / 128.f, &s, &c); ct[tid] = c; st[tid] = s; }
  __syncthreads();
  const int q = tid & 127, kh = tid >> 7;
  const int k2 = q <= 64 ? q : q - 64;
  float acc[16];
#pragma unroll
  for (int kk = 0; kk < 16; ++kk) acc[kk] = 0.f;
#pragma unroll 1
  for (int cc = 0; cc < 128; ++cc) {
    int idx = (k2 * cc) & 127;
    float t = q <= 64 ? ct[idx] : -st[idx];
#pragma unroll
    for (int kk = 0; kk < 16; ++kk) acc[kk] += a[(kh * 16 + kk) * 128 + cc] * t;
  }
  bfr* dst = (bfr*)(p.ws + OFF_W0T) + (size_t)(g * 128 + q) * 1024 + k0 + kh * 16;
#pragma unroll
  for (int qq = 0; qq < 2; ++qq) {
    u32x4 v;
    v.x = pk2(acc[8 * qq + 0], acc[8 * qq + 1]); v.y = pk2(acc[8 * qq + 2], acc[8 * qq + 3]);
    v.z = pk2(acc[8 * qq + 4], acc[8 * qq + 5]); v.w = pk2(acc[8 * qq + 6], acc[8 * qq + 7]);
    *(u32x4*)(dst + 8 * qq) = v;
  }
  __syncthreads();
}

ITEMFN void p0_transpose(const Params& p, char* smem, int item) {
  const int tid = mytid();
  int nt = item >> 4;
  const int k0 = (item & 15) * 64;
  const float* src; int ld, coloff; bfr* dst;
  if (nt < 40) { src = p.in[I_IN0W]; ld = 3072; coloff = 512 + nt * 64; dst = (bfr*)(p.ws + OFF_W0T) + (size_t)(512 + nt * 64) * 1024; }
  else if (nt < 56) { nt -= 40; src = p.in[I_OUT0W]; ld = 1024; coloff = nt * 64; dst = (bfr*)(p.ws + OFF_WO0T) + (size_t)(nt * 64) * 1024; }
  else if (nt < 120) { nt -= 56; src = p.in[I_IN1W]; ld = 4096; coloff = nt * 64; dst = (bfr*)(p.ws + OFF_W1T) + (size_t)(nt * 64) * 1024; }
  else { nt -= 120; src = p.in[I_OUT1W]; ld = 1024; coloff = nt * 64; dst = (bfr*)(p.ws + OFF_WO1T) + (size_t)(nt * 64) * 1024; }
  float* t = (float*)smem;
#pragma unroll
  for (int i = 0; i < 4; ++i) {
    int idx = tid + 256 * i, kk = idx >> 4, c4 = idx & 15;
    f32x4 v = *(const f32x4*)(src + (size_t)(k0 + kk) * ld + coloff + 4 * c4);
    t[kk * 65 + 4 * c4 + 0] = v.x; t[kk * 65 + 4 * c4 + 1] = v.y; t[kk * 65 + 4 * c4 + 2] = v.z; t[kk * 65 + 4 * c4 + 3] = v.w;
  }
  __syncthreads();
#pragma unroll
  for (int i = 0; i < 2; ++i) {
    int idx = tid + 256 * i, nn = idx >> 3, kc = idx & 7;
    float f[8];
#pragma unroll
    for (int e = 0; e < 8; ++e) f[e] = t[(8 * kc + e) * 65 + nn];
    u32x4 v; v.x = pk2(f[0], f[1]); v.y = pk2(f[2], f[3]); v.z = pk2(f[4], f[5]); v.w = pk2(f[6], f[7]);
    *(u32x4*)(dst + (size_t)nn * 1024 + k0 + 8 * kc) = v;
  }
  __syncthreads();
}

ITEMFN void p0_cache(const Params& p, char* smem, int item) {
  const int tid = mytid();
  const int b = item >> 6, hd = (item >> 3) & 7, p0 = (item & 7) * 64;
  const float* ck = p.in[I_CK];
  const float* cv = p.in[I_CV];
  bfr* dk = (bfr*)(p.ws + OFF_CKB);
  bfr* dv = (bfr*)(p.ws + OFF_CVT);
  float* t = (float*)smem;
#pragma unroll
  for (int i = 0; i < 4; ++i) {
    int idx = tid + 256 * i, pp = idx >> 4, c4 = idx & 15;
    size_t so = ((size_t)(b * 512 + p0 + pp) * 8 + hd) * 64 + 4 * c4;
    f32x4 kv = *(const f32x4*)(ck + so);
    u32x2 o; o.x = pk2(kv.x, kv.y); o.y = pk2(kv.z, kv.w);
    *(u32x2*)(dk + ((size_t)(b * 8 + hd) * 512 + p0 + pp) * 64 + 4 * c4) = o;
    f32x4 v = *(const f32x4*)(cv + so);
    t[pp * 65 + 4 * c4 + 0] = v.x; t[pp * 65 + 4 * c4 + 1] = v.y; t[pp * 65 + 4 * c4 + 2] = v.z; t[pp * 65 + 4 * c4 + 3] = v.w;
  }
  __syncthreads();
#pragma unroll
  for (int i = 0; i < 2; ++i) {
    int idx = tid + 256 * i, dd = idx >> 3, pc = idx & 7;
    float f[8];
#pragma unroll
    for (int e = 0; e < 8; ++e) f[e] = t[(8 * pc + e) * 65 + dd];
    u32x4 v; v.x = pk2(f[0], f[1]); v.y = pk2(f[2], f[3]); v.z = pk2(f[4], f[5]); v.w = pk2(f[6], f[7]);
    *(u32x4*)(dv + ((size_t)(b * 8 + hd) * 64 + dd) * 512 + p0 + 8 * pc) = v;
  }
  __syncthreads();
}

ITEMFN void p0_hid(const Params& p, char* smem, int item) {
  const int tid = mytid();
  const int variant = item >= 16 ? 1 : 0;
  const int tb = variant ? item - 16 : item;
  const int L = variant ? 4096 : 256;
  float* w1s = (float*)smem;
  float* w2s = w1s + 2112;
  float* z = w2s + 4096;
  float* h1 = z + 144;
  for (int idx = tid; idx < 2112; idx += 256) w1s[idx] = p.in[I_FW1][idx];
  for (int idx = tid; idx < 4096; idx += 256) w2s[idx] = p.in[I_FW2][idx];
  const int tt = tid >> 6, j = tid & 63;
  const float b1 = p.in[I_FB1][j], f1 = p.in[I_FFR1][j], b2 = p.in[I_FB2][j], f2 = p.in[I_FFR2][j];
  float* hid = (float*)(p.ws + OFF_HID) + (variant ? 256 * 64 : 0);
  __syncthreads();
#pragma unroll 1
  for (int rd = 0; rd < 4; ++rd) {
    const int t = tb * 16 + rd * 4 + tt;
    if (j < 33) {
      float val;
      if (j == 0) val = (float)t / (float)(L - 1);
      else {
        int b = (j - 1) & 15;
        float f = 1e-4f + (float)b * ((15.0f - 1e-4f) / 15.0f);
        float w = (6.283185307179586f * (float)t) / (float)L;
        float a = f * w;
        val = j <= 16 ? cosf(a) : -sinf(a);
      }
      z[tt * 36 + j] = val;
    }
    __syncthreads();
    float pre = b1;
#pragma unroll
    for (int i = 0; i < 33; ++i) pre += z[tt * 36 + i] * w1s[i * 64 + j];
    h1[tt * 64 + j] = sinf(f1 * pre);
    __syncthreads();
    float pre2 = b2;
#pragma unroll 16
    for (int i = 0; i < 64; ++i) pre2 += h1[tt * 64 + i] * w2s[i * 64 + j];
    hid[(size_t)j * L + t] = sinf(f2 * pre2);
    __syncthreads();
  }
}

ITEMFN void norm_item(const Params& p, int item, int layer) {
  const int tid = mytid(), lane = tid & 63, wave = tid >> 6;
  const float* g = (layer ? p.in[I_NORM1G] : p.in[I_NORM0G]);
  const float* mod = (const float*)(p.ws + OFF_MOD) + layer * 9 * 3072;
  bfr* dst = (bfr*)(p.ws + (layer ? OFF_R2 : OFF_R1));
  for (int rr = 0; rr < 4; ++rr) {
    const int m = item * 16 + wave * 4 + rr;
    const float* xr = layer ? (const float*)p.out + (size_t)m * 1024
                            : (m < MP ? p.in[I_XP] + (size_t)m * 1024 : p.in[I_XS] + (size_t)(m - MP) * 1024);
    const int ci = m < MP ? 8 : (m - MP) >> 12;
    f32x4 v[4];
    float ss = 0.f;
#pragma unroll
    for (int i = 0; i < 4; ++i) {
      v[i] = *(const f32x4*)(xr + lane * 4 + 256 * i);
      ss += v[i].x * v[i].x + v[i].y * v[i].y + v[i].z * v[i].z + v[i].w * v[i].w;
    }
#pragma unroll
    for (int o = 32; o >= 1; o >>= 1) ss += __shfl_xor(ss, o);
    const float rs = rsqrtf(ss * (1.f / 1024.f) + 1e-6f);
#pragma unroll
    for (int i = 0; i < 4; ++i) {
      const int col = lane * 4 + 256 * i;
      f32x4 g4 = *(const f32x4*)(g + col);
      f32x4 sh = *(const f32x4*)(mod + ci * 3072 + col);
      f32x4 sc = *(const f32x4*)(mod + ci * 3072 + 1024 + col);
      float a = v[i].x * rs * g4.x * (1.f + sc.x) + sh.x;
      float b = v[i].y * rs * g4.y * (1.f + sc.y) + sh.y;
      float c = v[i].z * rs * g4.z * (1.f + sc.z) + sh.z;
      float d = v[i].w * rs * g4.w * (1.f + sc.w) + sh.w;
      u32x2 o; o.x = pk2(a, b); o.y = pk2(c, d);
      *(u32x2*)(dst + (size_t)m * 1024 + col) = o;
    }
  }
}

template <int NT>
DI void filt_body(const Params& p, float* wl, float* red, int tid, int variant, int order, int w0) {
  constexpr int L = NT * 256;
  const float* hid = (const float*)(p.ws + OFF_HID) + (variant ? 256 * 64 : 0);
  float* F = (float*)(p.ws + (variant ? OFF_F4096 : OFF_F256));
  float acc[NT][8];
#pragma unroll
  for (int i = 0; i < NT; ++i)
#pragma unroll
    for (int c8 = 0; c8 < 8; ++c8) acc[i][c8] = 0.f;
#pragma unroll 4
  for (int k = 0; k < 64; ++k) {
    float hv[NT];
#pragma unroll
    for (int i = 0; i < NT; ++i) hv[i] = hid[(size_t)k * L + tid + 256 * i];
    const f32x4 wa = *(const f32x4*)(wl + k * 8);
    const f32x4 wb = *(const f32x4*)(wl + k * 8 + 4);
#pragma unroll
    for (int i = 0; i < NT; ++i) {
      acc[i][0] += hv[i] * wa.x; acc[i][1] += hv[i] * wa.y; acc[i][2] += hv[i] * wa.z; acc[i][3] += hv[i] * wa.w;
      acc[i][4] += hv[i] * wb.x; acc[i][5] += hv[i] * wb.y; acc[i][6] += hv[i] * wb.z; acc[i][7] += hv[i] * wb.w;
    }
  }
  const float MIND = -3.0701134573253947f, MAXD = -15.350567286626973f;
  float asum[4] = {0.f, 0.f, 0.f, 0.f};
#pragma unroll
  for (int i = 0; i < NT; ++i) {
    const int t = tid + 256 * i;
    const float tn = (float)t / (float)(L - 1);
#pragma unroll
    for (int wi = 0; wi < 4; ++wi) {
      const float delta = fabsf(MIND + (float)(w0 + wi) * ((MAXD - MIND) / 1023.f));
      const float dec = expf(-tn * delta);
#pragma unroll
      for (int dir = 0; dir < 2; ++dir) {
        const float val = acc[i][dir * 4 + wi] * dec;
        asum[wi] += fabsf(val);
        F[((size_t)(dir * 2 + order) * 1024 + w0 + wi) * L + t] = val;
      }
    }
  }
#pragma unroll
  for (int wi = 0; wi < 4; ++wi) {
#pragma unroll
    for (int o = 32; o >= 1; o >>= 1) asum[wi] += __shfl_xor(asum[wi], o);
  }
  if ((tid & 63) == 0) {
#pragma unroll
    for (int wi = 0; wi < 4; ++wi) red[(tid >> 6) * 4 + wi] = asum[wi];
  }
}

ITEMFN void filt_item(const Params& p, char* smem, int item) {
  const int tid = mytid();
  const int variant = item >> 9, order = (item >> 8) & 1, w0 = (item & 255) * 4;
  float* wl = (float*)smem;
  float* red = wl + 512;
  const float* w3 = p.in[I_FW3];
  for (int idx = tid; idx < 512; idx += 256) {
    int k = idx >> 3, c8 = idx & 7, dir = c8 >> 2, wi = c8 & 3;
    wl[idx] = w3[(size_t)k * 4096 + dir * 2048 + order * 1024 + w0 + wi];
  }
  __syncthreads();
  if (variant) filt_body<16>(p, wl, red, tid, variant, order, w0);
  else filt_body<1>(p, wl, red, tid, variant, order, w0);
  __syncthreads();
  if (tid < 4) {
    float* fsum = (float*)(p.ws + OFF_FSUM);
    fsum[(variant * 2 + order) * 1024 + w0 + tid] = red[tid] + red[4 + tid] + red[8 + tid] + red[12 + tid];
  }
  __syncthreads();
}

DI int swz(int row, int chunk) { return row * 128 + (((chunk ^ (row >> 1) ^ (row >> 4)) & 7) << 4); }

template <bool AT>
DI void g_load(u32x4 (&rx)[4], u32x4 (&rw)[4], const bfr* __restrict__ X, const bfr* __restrict__ W, int m0, int n0, int k0) {
  const int tid = mytid();
#pragma unroll
  for (int i = 0; i < 4; ++i) {
    const int row = (tid >> 3) + 32 * i, c = tid & 7;
    rw[i] = *(const u32x4*)(W + (size_t)(n0 + row) * 1024 + k0 + 8 * c);
    if (!AT) rx[i] = *(const u32x4*)(X + (size_t)(m0 + row) * 1024 + k0 + 8 * c);
  }
  if (AT) {
#pragma unroll
    for (int i = 0; i < 2; ++i) {
      const int idx = tid + 256 * i, mc = idx & 15, kp = idx >> 4;
      rx[2 * i] = *(const u32x4*)(X + (size_t)(k0 + 2 * kp) * MT + m0 + 8 * mc);
      rx[2 * i + 1] = *(const u32x4*)(X + (size_t)(k0 + 2 * kp + 1) * MT + m0 + 8 * mc);
    }
  }
}
template <bool AT>
DI void g_store(const u32x4 (&rx)[4], const u32x4 (&rw)[4], char* Xs, char* Ws) {
  const int tid = mytid();
#pragma unroll
  for (int i = 0; i < 4; ++i) {
    const int row = (tid >> 3) + 32 * i, c = tid & 7;
    *(u32x4*)(Ws + swz(row, c)) = rw[i];
    if (!AT) *(u32x4*)(Xs + swz(row, c)) = rx[i];
  }
  if (AT) {
#pragma unroll
    for (int i = 0; i < 2; ++i) {
      const int idx = tid + 256 * i, mc = idx & 15, kp = idx >> 4;
      const unsigned lo[4] = {rx[2 * i].x, rx[2 * i].y, rx[2 * i].z, rx[2 * i].w};
      const unsigned hi[4] = {rx[2 * i + 1].x, rx[2 * i + 1].y, rx[2 * i + 1].z, rx[2 * i + 1].w};
#pragma unroll
      for (int e = 0; e < 8; ++e) {
        const unsigned a = lo[e >> 1], b = hi[e >> 1];
        const unsigned val = (e & 1) ? ((a >> 16) | (b & 0xffff0000u)) : ((a & 0xffffu) | (b << 16));
        const int row = 8 * mc + e;
        *(unsigned*)(Xs + swz(row, kp >> 2) + (kp & 3) * 4) = val;
      }
    }
  }
}

template <bool AT, bool SWAP>
DI void gemm_main(f32x16 (&acc)[2][2], const bfr* __restrict__ X, const bfr* __restrict__ W, int m0, int n0, char* smem) {
  char* Xs = smem;
  char* Ws = smem + 16384;
  const int tid = mytid(), lane = tid & 63, wave = tid >> 6, r = lane & 31, h = lane >> 5;
  const int wm = wave >> 1, wn = wave & 1;
#pragma unroll
  for (int a = 0; a < 2; ++a)
#pragma unroll
    for (int b = 0; b < 2; ++b)
#pragma unroll
      for (int i = 0; i < 16; ++i) acc[a][b][i] = 0.f;
  u32x4 rx[4], rw[4];
  g_load<AT>(rx, rw, X, W, m0, n0, 0);
  for (int kt = 0; kt < 16; ++kt) {
    __syncthreads();
    g_store<AT>(rx, rw, Xs, Ws);
    __syncthreads();
    if (kt < 15) g_load<AT>(rx, rw, X, W, m0, n0, (kt + 1) * 64);
#pragma unroll
    for (int s = 0; s < 4; ++s) {
      bf16x8 xf[2], wf[2];
#pragma unroll
      for (int t = 0; t < 2; ++t) {
        xf[t] = *(const bf16x8*)(Xs + swz(64 * wm + 32 * t + r, 2 * s + h));
        wf[t] = *(const bf16x8*)(Ws + swz(64 * wn + 32 * t + r, 2 * s + h));
      }
#pragma unroll
      for (int a = 0; a < 2; ++a)
#pragma unroll
        for (int b = 0; b < 2; ++b) {
          if (SWAP) acc[a][b] = MFMA(wf[a], xf[b], acc[a][b]);
          else acc[a][b] = MFMA(xf[a], wf[b], acc[a][b]);
        }
    }
  }
}

DI void gemm_main_big(f32x16 (&acc)[4][2], const bfr* __restrict__ X, const bfr* __restrict__ W, int m0, int n0, char* smem) {
  char* Xs = smem;
  char* Ws = smem + 16384;
  const int tid = mytid(), lane = tid & 63, wave = tid >> 6, r = lane & 31, h = lane >> 5;
  const int wm = wave >> 1, wn = wave & 1;
#pragma unroll
  for (int a = 0; a < 4; ++a)
#pragma unroll
    for (int b = 0; b < 2; ++b)
#pragma unroll
      for (int i = 0; i < 16; ++i) acc[a][b][i] = 0.f;
  u32x4 rx[4], rw[8];
  const int lrow = tid >> 3, lc = tid & 7;
  const bfr* xp = X + (size_t)(m0 + lrow) * 1024 + 8 * lc;
  const bfr* wp = W + (size_t)(n0 + lrow) * 1024 + 8 * lc;
#pragma unroll
  for (int i = 0; i < 4; ++i) rx[i] = *(const u32x4*)(xp + (size_t)(32 * i) * 1024);
#pragma unroll
  for (int i = 0; i < 8; ++i) rw[i] = *(const u32x4*)(wp + (size_t)(32 * i) * 1024);
  for (int kt = 0; kt < 16; ++kt) {
    __syncthreads();
#pragma unroll
    for (int i = 0; i < 4; ++i) *(u32x4*)(Xs + swz(lrow + 32 * i, lc)) = rx[i];
#pragma unroll
    for (int i = 0; i < 8; ++i) *(u32x4*)(Ws + swz(lrow + 32 * i, lc)) = rw[i];
    __syncthreads();
    if (kt < 15) {
#pragma unroll
      for (int i = 0; i < 4; ++i) rx[i] = *(const u32x4*)(xp + (size_t)(32 * i) * 1024 + (kt + 1) * 64);
#pragma unroll
      for (int i = 0; i < 8; ++i) rw[i] = *(const u32x4*)(wp + (size_t)(32 * i) * 1024 + (kt + 1) * 64);
    }
#pragma unroll
    for (int s = 0; s < 4; ++s) {
      bf16x8 xf[2], wf[4];
#pragma unroll
      for (int t = 0; t < 2; ++t) xf[t] = *(const bf16x8*)(Xs + swz(64 * wm + 32 * t + r, 2 * s + h));
#pragma unroll
      for (int t = 0; t < 4; ++t) wf[t] = *(const bf16x8*)(Ws + swz(128 * wn + 32 * t + r, 2 * s + h));
#pragma unroll
      for (int a = 0; a < 4; ++a)
#pragma unroll
        for (int b = 0; b < 2; ++b) acc[a][b] = MFMA(wf[a], xf[b], acc[a][b]);
    }
  }
}

template <bool SILU>
DI void store_T4(const f32x16 (&acc)[4][2], bfr* dst, int nrow0, int mcol0, int r, int h) {
#pragma unroll
  for (int tn = 0; tn < 4; ++tn)
#pragma unroll
    for (int tm = 0; tm < 2; ++tm)
#pragma unroll
      for (int i = 0; i < 16; ++i) {
        float v = acc[tn][tm][i];
        if (SILU) v = siluf(v);
        dst[(size_t)(nrow0 + 32 * tn + crow(i, h)) * MT + mcol0 + 32 * tm + r] = f2bf(v);
      }
}

template <bool SILU>
DI void store_T4_lds(const f32x16 (&acc)[4][2], bfr* dst, int nrow0, int mcol0, char* smem, int wave, int lane) {
  const int r = lane & 31, h = lane >> 5;
  char* reg = smem + wave * 9216;
  __syncthreads();
#pragma unroll
  for (int half = 0; half < 2; ++half) {
#pragma unroll
    for (int t2 = 0; t2 < 2; ++t2)
#pragma unroll
      for (int tm = 0; tm < 2; ++tm)
#pragma unroll
        for (int i = 0; i < 16; ++i) {
          float v = acc[2 * half + t2][tm][i];
          if (SILU) v = siluf(v);
          *(bfr*)(reg + (32 * t2 + crow(i, h)) * 144 + (32 * tm + r) * 2) = f2bf(v);
        }
    __syncthreads();
#pragma unroll
    for (int q = 0; q < 8; ++q) {
      const int idx = lane + 64 * q, row = idx >> 3, ch = idx & 7;
      const u32x4 v = *(const u32x4*)(reg + row * 144 + ch * 16);
      __builtin_nontemporal_store(v, (u32x4*)(dst + (size_t)(nrow0 + 64 * half + row) * MT + mcol0 + 8 * ch));
    }
    __syncthreads();
  }
}

template <bool SILU>
DI void store_T(const f32x16 (&acc)[2][2], bfr* dst, int nrow0, int mcol0, int r, int h) {
#pragma unroll
  for (int tn = 0; tn < 2; ++tn)
#pragma unroll
    for (int tm = 0; tm < 2; ++tm)
#pragma unroll
      for (int i = 0; i < 16; ++i) {
        float v = acc[tn][tm][i];
        if (SILU) v = siluf(v);
        dst[(size_t)(nrow0 + 32 * tn + crow(i, h)) * MT + mcol0 + 32 * tm + r] = f2bf(v);
      }
}

template <int NT, int GN>
DI void tile_map(int lt, int x, int& mt, int& nt) {
  const int grp = lt / (8 * GN), in = lt % (8 * GN);
  const int lmh = grp / (NT / GN), nth = grp % (NT / GN);
  mt = (lmh * 8 + in / GN) * 8 + x;
  nt = nth * GN + in % GN;
}

ITEMFN void inproj0_tile(const Params& p, char* smem, int mt, int nt) {
  const int m0 = mt * 128, n0 = nt * 256;
  f32x16 acc[4][2];
  gemm_main_big(acc, (const bfr*)(p.ws + OFF_R1), (const bfr*)(p.ws + OFF_W0T), m0, n0, smem);
  const int tid = mytid(), lane = tid & 63, wave = tid >> 6, r = lane & 31, h = lane >> 5;
  const int mb = m0 + 64 * (wave >> 1), nb = n0 + 128 * (wave & 1);
  if (n0 < 512) { store_T4_lds<false>(acc, (bfr*)(p.ws + OFF_R2), nb, mb, smem, wave, lane); return; }
  const int region = (n0 - 512) >> 9;
  const int nl = nb - 512 - region * 512;
  if (region == 0) { store_T4_lds<true>(acc, (bfr*)(p.ws + OFF_AGT), nl, mb, smem, wave, lane); return; }
  if (region == 4) { store_T4_lds<true>(acc, (bfr*)(p.ws + OFF_BGT), nl, mb, smem, wave, lane); return; }
  if (region == 3) {
    store_T4_lds<false>(acc, (bfr*)(p.ws + OFF_VT), nl, mb, smem, wave, lane);
    if (m0 < MP) {
      float* ov = p.out + OUT_V;
#pragma unroll
      for (int tn = 0; tn < 4; ++tn)
#pragma unroll
        for (int tm = 0; tm < 2; ++tm)
#pragma unroll
          for (int g4 = 0; g4 < 4; ++g4) {
            f32x4 o; o.x = acc[tn][tm][4 * g4]; o.y = acc[tn][tm][4 * g4 + 1]; o.z = acc[tn][tm][4 * g4 + 2]; o.w = acc[tn][tm][4 * g4 + 3];
            *(f32x4*)(ov + (size_t)(mb + 32 * tm + r) * 512 + nl + 32 * tn + 8 * g4 + 4 * h) = o;
          }
    }
    return;
  }
  const float* gg = (region == 1 ? p.in[I_QNG] : p.in[I_KNG]);
  const float qs = region == 1 ? 0.125f * 1.4426950408889634f : 1.f;
  bfr* dst = (bfr*)(p.ws + (region == 1 ? OFF_Q : OFF_K));
#pragma unroll
  for (int tm = 0; tm < 2; ++tm) {
    const int m = mb + 32 * tm + r;
#pragma unroll
    for (int hh = 0; hh < 2; ++hh) {
      float ss = 0.f;
#pragma unroll
      for (int t2 = 0; t2 < 2; ++t2)
#pragma unroll
        for (int i = 0; i < 16; ++i) ss += acc[2 * hh + t2][tm][i] * acc[2 * hh + t2][tm][i];
      ss += __shfl_xor(ss, 32);
      const float rs = rsqrtf(ss * (1.f / 64.f) + 1e-6f);
#pragma unroll
      for (int t2 = 0; t2 < 2; ++t2)
#pragma unroll
        for (int g4 = 0; g4 < 4; ++g4) {
          const int d0 = 32 * t2 + 8 * g4 + 4 * h;
          f32x4 gv = *(const f32x4*)(gg + d0);
          f32x4 o;
          o.x = acc[2 * hh + t2][tm][4 * g4] * rs * gv.x; o.y = acc[2 * hh + t2][tm][4 * g4 + 1] * rs * gv.y;
          o.z = acc[2 * hh + t2][tm][4 * g4 + 2] * rs * gv.z; o.w = acc[2 * hh + t2][tm][4 * g4 + 3] * rs * gv.w;
          const int col = nl + 64 * hh + d0;
          if (region == 2 && m0 < MP) *(f32x4*)(p.out + OUT_K + (size_t)m * 512 + col) = o;
          u32x2 ob; ob.x = pk2(o.x * qs, o.y * qs); ob.y = pk2(o.z * qs, o.w * qs);
          *(u32x2*)(dst + (size_t)m * 512 + col) = ob;
        }
    }
  }
}

ITEMFN void inproj1_tile(const Params& p, char* smem, int mt, int nt) {
  const int m0 = mt * 128, n0 = nt * 256;
  f32x16 acc[4][2];
  gemm_main_big(acc, (const bfr*)(p.ws + OFF_R2), (const bfr*)(p.ws + OFF_W1T), m0, n0, smem);
  const int tid = mytid(), lane = tid & 63, wave = tid >> 6, r = lane & 31, h = lane >> 5;
  store_T4_lds<false>(acc, (bfr*)(p.ws + OFF_BIG), n0 + 128 * (wave & 1), m0 + 64 * (wave >> 1), smem, wave, lane);
}

ITEMFN void outproj_tile(const Params& p, char* smem, int mt, int nt, int layer) {
  const int m0 = mt * 128, n0 = nt * 128;
  f32x16 acc[2][2];
  gemm_main<false, false>(acc, (const bfr*)(p.ws + (layer ? OFF_BIG : OFF_R2)), (const bfr*)(p.ws + (layer ? OFF_WO1T : OFF_WO0T)), m0, n0, smem);
  const int tid = mytid(), lane = tid & 63, wave = tid >> 6, r = lane & 31, h = lane >> 5;
  const int mb = m0 + 64 * (wave >> 1), nb = n0 + 64 * (wave & 1);
  const float* mod = (const float*)(p.ws + OFF_MOD) + layer * 9 * 3072;
  const int ci = m0 < MP ? 8 : (m0 - MP) >> 12;
#pragma unroll
  for (int tm = 0; tm < 2; ++tm)
#pragma unroll
    for (int tn = 0; tn < 2; ++tn) {
      const int n = nb + 32 * tn + r;
      const float gate = mod[ci * 3072 + 2048 + n];
#pragma unroll
      for (int i = 0; i < 16; ++i) {
        const int m = mb + 32 * tm + crow(i, h);
        float xin;
        if (layer) xin = __builtin_nontemporal_load(p.out + (size_t)m * 1024 + n);
        else xin = m < MP ? __builtin_nontemporal_load(p.in[I_XP] + (size_t)m * 1024 + n) : __builtin_nontemporal_load(p.in[I_XS] + (size_t)(m - MP) * 1024 + n);
        const float res = xin + gate * acc[tm][tn][i];
        if (layer) __builtin_nontemporal_store(res, p.out + (size_t)m * 1024 + n);
        else p.out[(size_t)m * 1024 + n] = res;
      }
    }
}

ITEMFN void xpose_item(const Params& p, char* smem, int item, int layer) {
  const int tid = mytid();
  const bfr* src = (const bfr*)(p.ws + (layer ? OFF_R2 : OFF_R1));
  bfr* dst = (bfr*)(p.ws + (layer ? OFF_BIG : OFF_R2));
  const int k0 = (item & 15) * 64, m0 = (item >> 4) * 64;
  unsigned* t = (unsigned*)smem;
  {
    const int mc = tid & 7, kp = tid >> 3;
    const u32x4 a = *(const u32x4*)(src + (size_t)(k0 + 2 * kp) * MT + m0 + 8 * mc);
    const u32x4 b = *(const u32x4*)(src + (size_t)(k0 + 2 * kp + 1) * MT + m0 + 8 * mc);
    const unsigned lo[4] = {a.x, a.y, a.z, a.w};
    const unsigned hi[4] = {b.x, b.y, b.z, b.w};
#pragma unroll
    for (int e = 0; e < 8; ++e) {
      const unsigned x = lo[e >> 1], y = hi[e >> 1];
      const unsigned val = (e & 1) ? ((x >> 16) | (y & 0xffff0000u)) : ((x & 0xffffu) | (y << 16));
      t[(8 * mc + e) * 33 + kp] = val;
    }
  }
  __syncthreads();
#pragma unroll
  for (int i = 0; i < 2; ++i) {
    const int idx = tid + 256 * i, c = idx & 7, m = idx >> 3;
    u32x4 v;
    v.x = t[m * 33 + 4 * c + 0]; v.y = t[m * 33 + 4 * c + 1]; v.z = t[m * 33 + 4 * c + 2]; v.w = t[m * 33 + 4 * c + 3];
    *(u32x4*)(dst + (size_t)(m0 + m) * 1024 + k0 + 8 * c) = v;
  }
  __syncthreads();
}

struct AttnState { f32x16 o[2]; float mrun, lrun; };

DI void kv_gload(u32x4 (&kr)[2], u32x4 (&vr)[2], const bfr* kptr, size_t kstride, const bfr* vptr, size_t vstride, int tid) {
#pragma unroll
  for (int i = 0; i < 2; ++i) {
    const int idx = tid + 256 * i, row = idx >> 3, c = idx & 7;
    kr[i] = *(const u32x4*)(kptr + (size_t)row * kstride + 8 * c);
    vr[i] = *(const u32x4*)(vptr + (size_t)row * vstride + 8 * c);
  }
}
DI void kv_lstore(const u32x4 (&kr)[2], const u32x4 (&vr)[2], char* Ks, char* Vs, int tid) {
#pragma unroll
  for (int i = 0; i < 2; ++i) {
    const int idx = tid + 256 * i, row = idx >> 3, c = idx & 7;
    *(u32x4*)(Ks + row * 144 + c * 16) = kr[i];
    *(u32x4*)(Vs + row * 144 + c * 16) = vr[i];
  }
}

template <bool LOCAL>
DI void attn_chunk(AttnState& st, const bf16x8 (&qf)[4], const char* Ks, const char* Vs, int r, int h,
                   const float* brow, int qc, int cs) {
#pragma unroll
  for (int kt = 0; kt < 2; ++kt) {
    f32x16 s;
#pragma unroll
    for (int i = 0; i < 16; ++i) s[i] = 0.f;
#pragma unroll
    for (int sd = 0; sd < 4; ++sd) {
      bf16x8 kf = *(const bf16x8*)(Ks + (kt * 32 + r) * 144 + (16 * sd + 8 * h) * 2);
      s = MFMA(kf, qf[sd], s);
    }
    if (LOCAL) {
#pragma unroll
      for (int i = 0; i < 16; ++i) {
        const int kc = kt * 32 + crow(i, h);
        const bool valid = (kc >= cs) && (kc < cs + 16);
        const int bi = clampi(kc - qc + 15, 0, 30);
        s[i] = valid ? s[i] + brow[bi] : -INFINITY;
      }
    }
    float mx = s[0];
#pragma unroll
    for (int i = 1; i < 16; ++i) mx = fmaxf(mx, s[i]);
    mx = fmaxf(mx, __shfl_xor(mx, 32));
    if (__builtin_amdgcn_ballot_w64(mx - st.mrun > 8.0f) != 0ull) {
      const float mnew = fmaxf(st.mrun, mx);
      const float alpha = __builtin_amdgcn_exp2f(st.mrun - mnew);
      st.lrun *= alpha;
#pragma unroll
      for (int td = 0; td < 2; ++td)
#pragma unroll
        for (int i = 0; i < 16; ++i) st.o[td][i] *= alpha;
      st.mrun = mnew;
    }
    float ps = 0.f;
#pragma unroll
    for (int i = 0; i < 16; ++i) { s[i] = __builtin_amdgcn_exp2f(s[i] - st.mrun); ps += s[i]; }
    st.lrun += ps;
#pragma unroll
    for (int sp = 0; sp < 2; ++sp) {
      bf16x8 pf;
#pragma unroll
      for (int j = 0; j < 8; ++j) pf[j] = (short)f2bf(s[8 * sp + j]);
#pragma unroll
      for (int td = 0; td < 2; ++td) {
        const char* vp = Vs + (32 * td + r) * 144 + (kt * 32 + 16 * sp + 4 * h) * 2;
        s16x4 lo = *(const s16x4*)vp;
        s16x4 hi = *(const s16x4*)(vp + 16);
        bf16x8 vf;
        vf[0] = lo[0]; vf[1] = lo[1]; vf[2] = lo[2]; vf[3] = lo[3];
        vf[4] = hi[0]; vf[5] = hi[1]; vf[6] = hi[2]; vf[7] = hi[3];
        st.o[td] = MFMA(vf, pf, st.o[td]);
      }
    }
  }
}

DI void attn_finish(const Params& p, AttnState& st, int hd, size_t m, int h) {
  const float l = st.lrun + __shfl_xor(st.lrun, 32);
  const float inv = 1.f / l;
  const bfr* bg = (const bfr*)(p.ws + OFF_BGT);
  bfr* dst = (bfr*)(p.ws + OFF_R1);
#pragma unroll
  for (int td = 0; td < 2; ++td)
#pragma unroll
    for (int i = 0; i < 16; ++i) {
      const int d = 32 * td + crow(i, h);
      const float g = bf2f(bg[(size_t)(hd * 64 + d) * MT + m]);
      dst[(size_t)(512 + hd * 64 + d) * MT + m] = f2bf(st.o[td][i] * inv * g);
    }
}

DI void attn_init(AttnState& st) {
#pragma unroll
  for (int td = 0; td < 2; ++td)
#pragma unroll
    for (int i = 0; i < 16; ++i) st.o[td][i] = 0.f;
  st.mrun = -INFINITY;
  st.lrun = 0.f;
}

ITEMFN void attn_na_item(const Params& p, char* smem, int item) {
  const int tid = mytid(), lane = tid & 63, wave = tid >> 6, r = lane & 31, h = lane >> 5;
  const int b = item >> 8, hd = (item >> 5) & 7, rp = item & 31;
  float* bias = (float*)(smem + 36864);
  const size_t mbase = MP + (size_t)b * 4096;
  const int r0 = 2 * rp, qr = r0 + (wave >> 1), c0 = 32 * (wave & 1);
  const int kr0 = clampi(r0 - 4, 0, 56), kr_end = clampi(r0 - 3, 0, 56) + 8;
  const int rsw = clampi(qr - 4, 0, 56);
  const int nch = 8 + (kr_end - kr0);
  __syncthreads();
  for (int idx = tid; idx < 465; idx += 256) bias[idx] = p.in[I_RELB][hd * 465 + idx] * 1.4426950408889634f;
  const size_t mq = mbase + qr * 64 + c0 + r;
  const bfr* qp = (const bfr*)(p.ws + OFF_Q) + mq * 512 + hd * 64;
  bf16x8 qf[4];
#pragma unroll
  for (int sd = 0; sd < 4; ++sd) qf[sd] = *(const bf16x8*)(qp + 16 * sd + 8 * h);
  AttnState st;
  attn_init(st);
  const bfr* ckb = (const bfr*)(p.ws + OFF_CKB) + (size_t)(b * 8 + hd) * 512 * 64;
  const bfr* cvt = (const bfr*)(p.ws + OFF_CVT) + (size_t)(b * 8 + hd) * 64 * 512;
  const bfr* kb = (const bfr*)(p.ws + OFF_K) + mbase * 512 + hd * 64;
  const bfr* vt = (const bfr*)(p.ws + OFF_VT) + (size_t)(hd * 64) * MT + mbase;
  const int qc = c0 + r, cs = clampi(qc - 8, 0, 48);
  u32x4 kreg[2], vreg[2];
  kv_gload(kreg, vreg, ckb, 64, cvt, 512, tid);
  kv_lstore(kreg, vreg, smem, smem + 9216, tid);
  __syncthreads();
#pragma unroll 1
  for (int c = 0; c < nch; ++c) {
    char* Ks = smem + (c & 1) * 18432;
    char* Vs = Ks + 9216;
    if (c + 1 < nch) {
      const int cn = c + 1;
      if (cn < 8) kv_gload(kreg, vreg, ckb + (size_t)cn * 64 * 64, 64, cvt + cn * 64, 512, tid);
      else { const int kr = kr0 + cn - 8; kv_gload(kreg, vreg, kb + (size_t)kr * 64 * 512, 512, vt + kr * 64, MT, tid); }
    }
    if (c < 8) attn_chunk<false>(st, qf, Ks, Vs, r, h, nullptr, 0, 0);
    else {
      const int kr = kr0 + c - 8;
      if (kr >= rsw && kr < rsw + 8) attn_chunk<true>(st, qf, Ks, Vs, r, h, bias + (kr - qr + 7) * 31, qc, cs);
    }
    if (c + 1 < nch) kv_lstore(kreg, vreg, smem + ((c + 1) & 1) * 18432, smem + ((c + 1) & 1) * 18432 + 9216, tid);
    __syncthreads();
  }
  attn_finish(p, st, hd, mq, h);
}

ITEMFN void attn_ctx_item(const Params& p, char* smem, int item) {
  const int tid = mytid(), lane = tid & 63, wave = tid >> 6, r = lane & 31, h = lane >> 5;
  const int b = item >> 4, hd = (item >> 1) & 7, qh = item & 1;
  const size_t mbase = (size_t)b * 256;
  const size_t mq = mbase + qh * 128 + wave * 32 + r;
  const bfr* qp = (const bfr*)(p.ws + OFF_Q) + mq * 512 + hd * 64;
  bf16x8 qf[4];
#pragma unroll
  for (int sd = 0; sd < 4; ++sd) qf[sd] = *(const bf16x8*)(qp + 16 * sd + 8 * h);
  AttnState st;
  attn_init(st);
  const bfr* kb = (const bfr*)(p.ws + OFF_K) + mbase * 512 + hd * 64;
  const bfr* vt = (const bfr*)(p.ws + OFF_VT) + (size_t)(hd * 64) * MT + mbase;
  u32x4 kreg[2], vreg[2];
  __syncthreads();
  kv_gload(kreg, vreg, kb, 512, vt, MT, tid);
  kv_lstore(kreg, vreg, smem, smem + 9216, tid);
  __syncthreads();
#pragma unroll 1
  for (int c = 0; c < 4; ++c) {
    char* Ks = smem + (c & 1) * 18432;
    char* Vs = Ks + 9216;
    if (c + 1 < 4) kv_gload(kreg, vreg, kb + (size_t)(c + 1) * 64 * 512, 512, vt + (c + 1) * 64, MT, tid);
    attn_chunk<false>(st, qf, Ks, Vs, r, h, nullptr, 0, 0);
    if (c + 1 < 4) kv_lstore(kreg, vreg, smem + ((c + 1) & 1) * 18432, smem + ((c + 1) & 1) * 18432 + 9216, tid);
    __syncthreads();
  }
  attn_finish(p, st, hd, mq, h);
}

DI void fft_fwd(cpx (&v)[16], cpx* buf, int tid) {
  __syncthreads();
  fft_fwd_pass<256, false, true>(v, buf, tid);
  __syncthreads();
  fft_fwd_pass<16, true, true>(v, buf, tid);
  __syncthreads();
  fft_fwd_pass<1, true, false>(v, buf, tid);
}
DI void fft_inv(cpx (&v)[16], cpx* buf, int tid) {
  __syncthreads();
  fft_inv_pass<1, false, true>(v, buf, tid);
  __syncthreads();
  fft_inv_pass<16, true, true>(v, buf, tid);
  __syncthreads();
  fft_inv_pass<256, true, false>(v, buf, tid);
}

DI void fft_fwd_lds(cpx (&v)[16], cpx* buf, int tid) {
  fft_fwd_pass<256, true, true>(v, buf, tid);
  __syncthreads();
  fft_fwd_pass<16, true, true>(v, buf, tid);
  __syncthreads();
  fft_fwd_pass<1, true, false>(v, buf, tid);
}
DI void fft_inv_lds(cpx (&v)[16], cpx* buf, int tid) {
  __syncthreads();
  fft_inv_pass<1, false, true>(v, buf, tid);
  __syncthreads();
  fft_inv_pass<16, true, true>(v, buf, tid);
  __syncthreads();
  fft_inv_pass<256, true, true>(v, buf, tid);
}

ITEMFN void fnet_item(const Params& p, char* smem, int item, bool prompt) {
  const int tid = mytid();
  cpx* buf = (cpx*)smem;
  float* rb = (float*)smem;
  const int sb = item / 260, rem = item - sb * 260, g = rem / 65, k2 = rem - g * 65;
  const size_t mbase = prompt ? (size_t)sb * 4096 : MP + (size_t)sb * 4096;
  const bool has_im = (k2 != 0) && (k2 != 64);
  const bfr* re = (const bfr*)(p.ws + OFF_R2) + (size_t)(g * 128 + k2) * MT + mbase;
  const bfr* im = (const bfr*)(p.ws + OFF_R2) + (size_t)(g * 128 + 64 + (has_im ? k2 : 1)) * MT + mbase;
  cpx v[16];
  float scale;
  if (!prompt) {
#pragma unroll
    for (int jj = 0; jj < 16; ++jj) { v[jj].x = bf2f(re[tid + 256 * jj]); v[jj].y = has_im ? bf2f(im[tid + 256 * jj]) : 0.f; }
    fft_fwd(v, buf, tid);
    __syncthreads();
    scale = 0.0013810679320049757f;
#pragma unroll
    for (int k = 0; k < 16; ++k) { const int idx = k * 256 + (tid & 15) * 16 + (tid >> 4); rb[idx + (idx >> 4)] = v[k].x * scale; }
  } else {
    const int base = (tid >> 4) * 256 + (tid & 15);
#pragma unroll
    for (int jj = 0; jj < 16; ++jj) { v[jj].x = bf2f(re[base + 16 * jj]); v[jj].y = has_im ? bf2f(im[base + 16 * jj]) : 0.f; }
    __syncthreads();
    fft_fwd_pass<16, false, true>(v, buf, tid);
    __syncthreads();
    fft_fwd_pass<1, true, false>(v, buf, tid);
    __syncthreads();
    scale = 0.005524271728019903f;
#pragma unroll
    for (int k = 0; k < 16; ++k) { const int idx = (tid >> 4) * 256 + k * 16 + (tid & 15); rb[idx + (idx >> 4)] = v[k].x * scale; }
  }
  __syncthreads();
  const int lmask = prompt ? 255 : 4095;
  {
    const int j1 = g * 128 + k2;
    const bfr* ag = (const bfr*)(p.ws + OFF_AGT) + (size_t)j1 * MT + mbase;
    bfr* dst = (bfr*)(p.ws + OFF_R1) + (size_t)j1 * MT + mbase;
#pragma unroll
    for (int i = 0; i < 2; ++i) {
      const int q0 = 8 * (tid + 256 * i);
      u32x4 a = *(const u32x4*)(ag + q0);
      const unsigned au[4] = {a.x, a.y, a.z, a.w};
      float f[8];
#pragma unroll
      for (int e = 0; e < 8; ++e) {
        const float gv = (e & 1) ? __uint_as_float(au[e >> 1] & 0xffff0000u) : __uint_as_float(au[e >> 1] << 16);
        f[e] = rb[q0 + (q0 >> 4) + e] * gv;
      }
      u32x4 o; o.x = pk2(f[0], f[1]); o.y = pk2(f[2], f[3]); o.z = pk2(f[4], f[5]); o.w = pk2(f[6], f[7]);
      *(u32x4*)(dst + q0) = o;
    }
  }
  if (has_im) {
    const int j2 = g * 128 + 128 - k2;
    const bfr* ag = (const bfr*)(p.ws + OFF_AGT) + (size_t)j2 * MT + mbase;
    bfr* dst = (bfr*)(p.ws + OFF_R1) + (size_t)j2 * MT + mbase;
#pragma unroll
    for (int i = 0; i < 2; ++i) {
      const int q0 = 8 * (tid + 256 * i);
      u32x4 a = *(const u32x4*)(ag + q0);
      const unsigned au[4] = {a.x, a.y, a.z, a.w};
      float f[8];
#pragma unroll
      for (int e = 0; e < 8; ++e) {
        const float gv = (e & 1) ? __uint_as_float(au[e >> 1] & 0xffff0000u) : __uint_as_float(au[e >> 1] << 16);
        const int k1 = q0 + e;
        const int src = (k1 & ~lmask) | ((lmask + 1 - (k1 & lmask)) & lmask);
        f[e] = rb[src + (src >> 4)] * gv;
      }
      u32x4 o; o.x = pk2(f[0], f[1]); o.y = pk2(f[2], f[3]); o.z = pk2(f[4], f[5]); o.w = pk2(f[6], f[7]);
      *(u32x4*)(dst + q0) = o;
    }
  }
  __syncthreads();
}

DI float conv3(const bfr* row, int n, int L, float w0, float w1, float w2, float bias) {
  const float a = n > 0 ? bf2f(row[n - 1]) : 0.f;
  const float b = bf2f(row[n]);
  const float c = n < L - 1 ? bf2f(row[n + 1]) : 0.f;
  return a * w0 + b * w1 + c * w2 + bias;
}

DI void stage_rows(bfr* l0, bfr* l1, const bfr* g0, const bfr* g1, int tid) {
#pragma unroll
  for (int i = 0; i < 2; ++i) {
    const int ch = tid + 256 * i;
    const u32x4 a = *(const u32x4*)(g0 + 8 * ch);
    const u32x4 b = *(const u32x4*)(g1 + 8 * ch);
    *(u32x4*)(l0 + 8 * ch) = a;
    *(u32x4*)(l1 + 8 * ch) = b;
  }
}
DI float conv3l(const bfr* row, int n, float w0, float w1, float w2, float bias) {
  const float a = bf2f(row[n > 0 ? n - 1 : 0]);
  const float b = bf2f(row[n]);
  const float c = bf2f(row[n < 4095 ? n + 1 : 4095]);
  return (n > 0 ? a : 0.f) * w0 + b * w1 + (n < 4095 ? c : 0.f) * w2 + bias;
}

ITEMFN void hyena_sample_item(const Params& p, char* smem, int c) {
  const int tid = mytid();
  cpx* buf = (cpx*)smem;
  bfr* raw0 = (bfr*)smem;
  bfr* raw1 = (bfr*)(smem + 8192);
  bfr* raw2 = (bfr*)(smem + 16384);
  bfr* raw3 = (bfr*)(smem + 24576);
  const float* scw = p.in[I_SCW];
  const float* scb = p.in[I_SCB];
  bfr* proj = (bfr*)(p.ws + OFF_BIG);
  bfr* P0 = proj + (size_t)c * MT + MP;
  bfr* P1 = proj + (size_t)(1024 + c) * MT + MP;
  const bfr* P2 = proj + (size_t)(2048 + c) * MT + MP;
  const bfr* PG = proj + (size_t)(3072 + c) * MT + MP;
  bfr* dst = (bfr*)(p.ws + OFF_R2) + (size_t)c * MT + MP;
  const float* fsum = (const float*)(p.ws + OFF_FSUM) + 2 * 1024;
  const float* F = (const float*)(p.ws + OFF_F4096);
#pragma unroll 1
  for (int order = 0; order < 2; ++order) {
    const float* hf = F + ((size_t)(0 * 2 + order) * 1024 + c) * 4096;
    const float* hb = F + ((size_t)(1 * 2 + order) * 1024 + c) * 4096;
    const float skip = p.in[I_FSKIP][order * 1024 + c];
    const int col1 = (order + 1) * 1024 + c;
    const float a0 = scw[c], a1 = scw[3072 + c], a2 = scw[6144 + c], ab = scb[c];
    const float m0 = scw[col1], m1 = scw[3072 + col1], m2 = scw[6144 + col1], mb = scb[col1];
    const bfr* PM = order == 0 ? P1 : P2;
    unsigned* ysc = order == 0 ? (unsigned*)dst : (unsigned*)P1;
    cpx G[16];
    {
    const float inv = 1.f / (fsum[order * 1024 + c] + 1e-6f);
    int tt = tid; OPAQUE(tt);
#pragma unroll
    for (int j = 0; j < 16; ++j) {
      const unsigned n = (unsigned)tt + 256u * j;
      const float a = hf[n] * inv + (n == 0u ? skip : 0.f);
      const float bq = n >= 1u ? hb[4096u - n] * inv : 0.f;
      G[j].x = a + bq; G[j].y = 0.f;
    }
    }
    fft_fwd(G, buf, tid);
#pragma unroll 1
    for (int pp = 0; pp < 4; ++pp) {
      int tq = tid; OPAQUE(tq);
      const bfr* r0 = P0 + (size_t)(2 * pp) * 4096;
      const bfr* r1 = P0 + (size_t)(2 * pp + 1) * 4096;
      cpx w[16];
      __syncthreads();
      stage_rows(raw0, raw1, r0, r1, tq);
      __syncthreads();
#pragma unroll
      for (int j = 0; j < 16; ++j) {
        const int n = tq + 256 * j;
        if (order == 0) { w[j].x = conv3l(raw0, n, a0, a1, a2, ab); w[j].y = conv3l(raw1, n, a0, a1, a2, ab); }
        else { w[j].x = bf2f(raw0[n]); w[j].y = bf2f(raw1[n]); }
      }
      fft_fwd(w, buf, tq);
#pragma unroll
      for (int k = 0; k < 16; ++k) w[k] = cmul(w[k], G[k]);
      fft_inv(w, buf, tq);
#pragma unroll
      for (int j = 0; j < 16; ++j) ysc[pp * 4096 + tq + 256 * j] = pk2(w[j].x * (1.f / 8192.f), w[j].y * (1.f / 8192.f));
    }
    {
    const float inv = 1.f / (fsum[order * 1024 + c] + 1e-6f);
    int tt = tid; OPAQUE(tt);
#pragma unroll
    for (int j = 0; j < 16; ++j) {
      const unsigned n = (unsigned)tt + 256u * j;
      const float a = hf[n] * inv + (n == 0u ? skip : 0.f);
      const float bq = n >= 1u ? hb[4096u - n] * inv : 0.f;
      float s, cs;
      SINCOSPI((float)n * (1.f / 4096.f), &s, &cs);
      const float d = a - bq;
      G[j].x = d * cs; G[j].y = -d * s;
    }
    }
    fft_fwd(G, buf, tid);
#pragma unroll 1
    for (int pp = 0; pp < 4; ++pp) {
      int tq = tid; OPAQUE(tq);
      bfr* r0 = P0 + (size_t)(2 * pp) * 4096;
      bfr* r1 = P0 + (size_t)(2 * pp + 1) * 4096;
      cpx w[16];
      __syncthreads();
      stage_rows(raw0, raw1, r0, r1, tq);
      __syncthreads();
#pragma unroll
      for (int j = 0; j < 16; ++j) {
        const int n = tq + 256 * j;
        cpx z;
        if (order == 0) { z.x = conv3l(raw0, n, a0, a1, a2, ab); z.y = conv3l(raw1, n, a0, a1, a2, ab); }
        else { z.x = bf2f(raw0[n]); z.y = bf2f(raw1[n]); }
        float s, cs;
        { int no = n; OPAQUE(no); SINCOSPI((float)no * (1.f / 4096.f), &s, &cs); }
        cpx tw; tw.x = cs; tw.y = -s;
        w[j] = cmul(z, tw);
      }
      fft_fwd(w, buf, tq);
#pragma unroll
      for (int k = 0; k < 16; ++k) w[k] = cmul(w[k], G[k]);
      fft_inv(w, buf, tq);
      unsigned ye[16];
#pragma unroll
      for (int j = 0; j < 16; ++j) ye[j] = ysc[pp * 4096 + tq + 256 * j];
      __syncthreads();
      stage_rows(raw0, raw1, PM + (size_t)(2 * pp) * 4096, PM + (size_t)(2 * pp + 1) * 4096, tq);
      if (order == 1) stage_rows(raw2, raw3, PG + (size_t)(2 * pp) * 4096, PG + (size_t)(2 * pp + 1) * 4096, tq);
      __syncthreads();
      bfr* o0 = order == 0 ? r0 : dst + (size_t)(2 * pp) * 4096;
      bfr* o1 = order == 0 ? r1 : dst + (size_t)(2 * pp + 1) * 4096;
#pragma unroll
      for (int j = 0; j < 16; ++j) {
        const int n = tq + 256 * j;
        float s, cs;
        { int no = n; OPAQUE(no); SINCOSPI((float)no * (1.f / 4096.f), &s, &cs); }
        cpx tw; tw.x = cs; tw.y = -s;
        const cpx yo = cmulc(w[j], tw);
        const float yx = __uint_as_float(ye[j] << 16) + yo.x * (1.f / 8192.f);
        const float yy = __uint_as_float(ye[j] & 0xffff0000u) + yo.y * (1.f / 8192.f);
        const float ux = conv3l(raw0, n, m0, m1, m2, mb);
        const float uy = conv3l(raw1, n, m0, m1, m2, mb);
        const float g0 = order == 0 ? 1.f : siluf(bf2f(raw2[n]));
        const float g1 = order == 0 ? 1.f : siluf(bf2f(raw3[n]));
        o0[n] = f2bf(ux * yx * g0);
        o1[n] = f2bf(uy * yy * g1);
      }
    }
    __syncthreads();
  }
}

ITEMFN void hyena_prompt_item(const Params& p, char* smem, int c) {
  const int tid = mytid();
  cpx* buf = (cpx*)smem;
  const float* scw = p.in[I_SCW];
  const float* scb = p.in[I_SCB];
  bfr* proj = (bfr*)(p.ws + OFF_BIG);
  bfr* P0 = proj + (size_t)c * MT;
  const bfr* P1 = proj + (size_t)(1024 + c) * MT;
  const bfr* P2 = proj + (size_t)(2048 + c) * MT;
  const bfr* PG = proj + (size_t)(3072 + c) * MT;
  bfr* dst = (bfr*)(p.ws + OFF_R2) + (size_t)c * MT;
  const float* fsum = (const float*)(p.ws + OFF_FSUM);
  const float* F = (const float*)(p.ws + OFF_F256);
#pragma unroll 1
  for (int order = 0; order < 2; ++order) {
    cpx G[16];
#pragma unroll
    for (int j = 0; j < 16; ++j) { G[j].x = 0.f; G[j].y = 0.f; }
    const float inv = 1.f / (fsum[order * 1024 + c] + 1e-6f);
    G[0].x = F[((size_t)(0 * 2 + order) * 1024 + c) * 256 + tid] * inv;
    if (tid >= 1) G[15].x = F[((size_t)(1 * 2 + order) * 1024 + c) * 256 + 256 - tid] * inv;
    fft_fwd(G, buf, tid);
    const float skip = p.in[I_FSKIP][order * 1024 + c];
    const int col1 = (order + 1) * 1024 + c;
    const float a0 = scw[c], a1 = scw[3072 + c], a2 = scw[6144 + c], ab = scb[c];
    const float m0 = scw[col1], m1 = scw[3072 + col1], m2 = scw[6144 + col1], mb = scb[col1];
    const bfr* PM = order == 0 ? P1 : P2;
#pragma unroll 1
    for (int cc = 0; cc < 2; ++cc) {
      cpx zr[8], w[16];
#pragma unroll
      for (int j = 0; j < 16; ++j) {
        if ((j & 1) == 0) {
          const size_t o0 = (size_t)(16 * cc + (j >> 1)) * 256, o1 = (size_t)(16 * cc + 8 + (j >> 1)) * 256;
          if (order == 0) { zr[j >> 1].x = conv3(P0 + o0, tid, 256, a0, a1, a2, ab); zr[j >> 1].y = conv3(P0 + o1, tid, 256, a0, a1, a2, ab); }
          else { zr[j >> 1].x = bf2f(P0[o0 + tid]); zr[j >> 1].y = bf2f(P0[o1 + tid]); }
          w[j] = zr[j >> 1];
        } else { w[j].x = 0.f; w[j].y = 0.f; }
      }
      fft_fwd(w, buf, tid);
#pragma unroll
      for (int k = 0; k < 16; ++k) w[k] = cmul(w[k], G[k]);
      fft_inv(w, buf, tid);
#pragma unroll
      for (int j = 0; j < 16; j += 2) {
        const size_t o0 = (size_t)(16 * cc + (j >> 1)) * 256, o1 = (size_t)(16 * cc + 8 + (j >> 1)) * 256;
        const float yx = w[j].x * (1.f / 4096.f) + skip * zr[j >> 1].x;
        const float yy = w[j].y * (1.f / 4096.f) + skip * zr[j >> 1].y;
        const float ux = conv3(PM + o0, tid, 256, m0, m1, m2, mb);
        const float uy = conv3(PM + o1, tid, 256, m0, m1, m2, mb);
        if (order == 0) {
          P0[o0 + tid] = f2bf(ux * yx);
          P0[o1 + tid] = f2bf(uy * yy);
        } else {
          const float g0 = siluf(bf2f(PG[o0 + tid]));
          const float g1 = siluf(bf2f(PG[o1 + tid]));
          dst[o0 + tid] = f2bf(ux * yx * g0);
          dst[o1 + tid] = f2bf(uy * yy * g1);
        }
      }
    }
    __syncthreads();
  }
}


#define XB_TMO      128
#define XB_XCNT(j)  (256  + 64 * (j))
#define XB_XSUB(j)  (1280 + 64 * (j))
#define XB_XGEN(j)  (2304 + 64 * (j))
#define XB_TOP      3328
#define XB_TOPGEN   3392
#define XCD_BAR_WORDS 3456
#define XB_SPIN_CAP (1u << 18)
#define LAS __attribute__((address_space(3)))
__device__ __forceinline__ unsigned xb_ld(unsigned* p)              { return __hip_atomic_load(p, __ATOMIC_RELAXED, __HIP_MEMORY_SCOPE_AGENT); }
__device__ __forceinline__ unsigned xb_add(unsigned* p, unsigned v) { return __hip_atomic_fetch_add(p, v, __ATOMIC_RELAXED, __HIP_MEMORY_SCOPE_AGENT); }
__device__ __forceinline__ unsigned xb_xcc_id() { return (unsigned)__builtin_amdgcn_s_getreg((3 << 11) | 20) & 0xFu; }
#define XB_SPIN(cond, bar) do { unsigned _sp = 0; while (cond) { __builtin_amdgcn_s_sleep(1); \
    if ((++_sp & 255u) == 0u) { if (xb_ld(&(bar)[XB_TMO])) break; if (_sp > XB_SPIN_CAP) { atomicAdd(&(bar)[XB_TMO], 1u); break; } } } } while (0)
struct XcdBarrier { unsigned* bar; unsigned x; volatile LAS unsigned* st; };
__device__ __forceinline__ XcdBarrier xcd_barrier_post(unsigned* bar, volatile LAS unsigned* st) {
    XcdBarrier b; b.bar = bar; b.x = xb_xcc_id(); b.st = st;
    if (threadIdx.x == 0) (void)xb_add(&bar[XB_XCNT(b.x)], 1u);
    return b;
}
__device__ __forceinline__ void xcd_barrier_complete(unsigned* bar, unsigned x, unsigned& nloc, unsigned& nx) {
    const unsigned G = gridDim.x * gridDim.y * gridDim.z;
    unsigned sum, cnt, mine, sp = 0u;
    for (;;) {
        sum = 0u; cnt = 0u; mine = 0u;
#pragma unroll
        for (unsigned j = 0; j < 16; ++j) { const unsigned c = xb_ld(&bar[XB_XCNT(j)]); sum += c; cnt += (c > 0u) ? 1u : 0u; mine = (j == x) ? c : mine; }
        if (sum == G) break;
        __builtin_amdgcn_s_sleep(1);
        if ((++sp & 255u) == 0u) { if (xb_ld(&bar[XB_TMO])) break; if (sp > XB_SPIN_CAP) { atomicAdd(&bar[XB_TMO], 1u); break; } }
    }
    nloc = mine > 0u ? mine : 1u; nx = cnt > 0u ? cnt : 1u;
}
__device__ __forceinline__ void xcd_barrier(const XcdBarrier& b) {
    asm volatile("s_waitcnt vmcnt(0)" ::: "memory");
    __syncthreads();
    if (threadIdx.x == 0) {
        unsigned* bar = b.bar;
        __builtin_amdgcn_s_waitcnt(0);
        unsigned nloc = b.st[0], nx = b.st[1];
        if (nloc == 0u) { xcd_barrier_complete(bar, b.x, nloc, nx); b.st[0] = nloc; b.st[1] = nx; }
        const unsigned old = xb_add(&bar[XB_XSUB(b.x)], 1u);
        const unsigned gen = old / nloc;
        if (old + 1u == (gen + 1u) * nloc) {
            __builtin_amdgcn_fence(__ATOMIC_RELEASE, "agent");
            asm volatile("s_waitcnt vmcnt(0)" ::: "memory");
            const unsigned og = xb_add(&bar[XB_TOP], 1u);
            const unsigned tg = og / nx;
            if (og + 1u == (tg + 1u) * nx) xb_add(&bar[XB_TOPGEN], 1u);
            else XB_SPIN(xb_ld(&bar[XB_TOPGEN]) == tg, bar);
            __builtin_amdgcn_fence(__ATOMIC_ACQUIRE, "agent");
            xb_add(&bar[XB_XGEN(b.x)], 1u);
            asm volatile("s_waitcnt vmcnt(0)" ::: "memory");
        } else {
            XB_SPIN(xb_ld(&bar[XB_XGEN(b.x)]) == gen, bar);
            __builtin_amdgcn_fence(__ATOMIC_ACQUIRE, "agent");
            asm volatile("s_waitcnt vmcnt(0)" ::: "memory");
        }
    }
    __syncthreads();
}

__global__ void __launch_bounds__(256, 2) mega(Params p, int ph_lo, int ph_hi) {
  __shared__ __attribute__((aligned(16))) char smem[49152];
  __shared__ u32x4 xb_words;
  if (threadIdx.x == 0) xb_words = u32x4{0u, 0u, 0u, 0u};
  __syncthreads();
  if (ph_lo > 4096) cg::this_grid().sync();
  const XcdBarrier xb = xcd_barrier_post((unsigned*)(p.ws + OFF_BAR), (volatile LAS unsigned*)&xb_words);
  const int bid = blockIdx.x, nb = gridDim.x;
#pragma unroll
  for (int ph = 0; ph < NPH; ++ph) {
    if (ph < ph_lo || ph >= ph_hi) continue;
    if (ph > ph_lo) {
      xcd_barrier(xb);
    }
#pragma unroll
    for (int rep = 0; rep < 1 + ((DUP_MASK >> ph) & 1); ++rep)
    switch (ph) {
      case 0:
        for (int it = bid; it < 3280; it += nb) {
          if (it < 192) p0_mod(p, smem, it);
          else if (it < 320) p0_fold(p, smem, it - 192);
          else if (it < 592) p0_hid(p, smem, it - 320);
          else if (it < 2768) p0_transpose(p, smem, it - 592);
          else p0_cache(p, smem, it - 2768);
        }
        break;
      case 1:
        for (int it = bid; it < 1024 + 2560; it += nb) {
          if (it < 1024) filt_item(p, smem, 1023 - it);
          else norm_item(p, it - 1024, 0);
        }
        break;
      case 2:
        if ((nb & 7) == 0) { for (int lt = bid >> 3; lt < 40 * 12; lt += nb >> 3) { int mt, nt; tile_map<12, 4>(lt, bid & 7, mt, nt); inproj0_tile(p, smem, mt, nt); } }
        else { for (int t = bid; t < 320 * 12; t += nb) inproj0_tile(p, smem, t / 12, t % 12); }
        break;
      case 3:
        for (int k = 0; bid + k * nb < 5160; ++k) {
          const int cnt = (5160 - bid + nb - 1) / nb;
          const int it = bid + ((bid >= (nb >> 1)) ? (cnt - 1 - k) : k) * nb;
          if (it < 2048) attn_na_item(p, smem, it);
          else if (it < 2560) attn_ctx_item(p, smem, it - 2048);
          else if (it < 4640) fnet_item(p, smem, it - 2560, false);
          else fnet_item(p, smem, it - 4640, true);
        }
        break;
      case 4:
        for (int it = bid; it < 10240; it += nb) xpose_item(p, smem, it, 0);
        break;
      case 5:
        if ((nb & 7) == 0) { for (int lt = bid >> 3; lt < 40 * 8; lt += nb >> 3) { int mt, nt; tile_map<8, 8>(lt, bid & 7, mt, nt); outproj_tile(p, smem, mt, nt, 0); } }
        else { for (int t = bid; t < 320 * 8; t += nb) outproj_tile(p, smem, t >> 3, t & 7, 0); }
        break;
      case 6:
        for (int it = bid; it < 2560; it += nb) norm_item(p, it, 1);
        break;
      case 7:
        if ((nb & 7) == 0) { for (int lt = bid >> 3; lt < 40 * 16; lt += nb >> 3) { int mt, nt; tile_map<16, 8>(lt, bid & 7, mt, nt); inproj1_tile(p, smem, mt, nt); } }
        else { for (int t = bid; t < 320 * 16; t += nb) inproj1_tile(p, smem, t >> 4, t & 15); }
        break;
      case 8:
        for (int it = bid; it < 2048; it += nb) {
          if (it < 1024) hyena_sample_item(p, smem, it);
          else hyena_prompt_item(p, smem, it - 1024);
        }
        break;
      case 9:
        for (int it = bid; it < 10240; it += nb) xpose_item(p, smem, it, 1);
        break;
      case 10:
        if ((nb & 7) == 0) { for (int lt = bid >> 3; lt < 40 * 8; lt += nb >> 3) { int mt, nt; tile_map<8, 8>(lt, bid & 7, mt, nt); outproj_tile(p, smem, mt, nt, 1); } }
        else { for (int t = bid; t < 320 * 8; t += nb) outproj_tile(p, smem, t >> 3, t & 7, 1); }
        break;
    }
  }
}

extern "C" void kernel_launch(void* const* d_in, const int* in_sizes, int n_in, void* d_out, int out_size, void* d_ws,
                              size_t ws_size, hipStream_t stream) {
  Params p{};
  for (int i = 0; i < 29; ++i) p.in[i] = (const float*)d_in[i];
  p.out = (float*)d_out;
  p.ws = (char*)d_ws;
  if (ws_size < WS_NEEDED) { fprintf(stderr, "workspace too small: %zu < %zu\n", ws_size, (size_t)WS_NEEDED); return; }
  static int grid_blocks = 0;
  if (!grid_blocks) {
    int dev = 0, cus = 0, per_cu = 0;
    hipGetDevice(&dev);
    hipDeviceGetAttribute(&cus, hipDeviceAttributeMultiprocessorCount, dev);
    hipOccupancyMaxActiveBlocksPerMultiprocessor(&per_cu, mega, 256, 0);
    if (per_cu > 2) per_cu = 2;
    grid_blocks = cus * per_cu;
  }
  hipMemsetAsync((char*)d_ws + OFF_BAR, 0, 16384, stream);
#if SINGLE_LAUNCH
  int lo = 0, hi = NPH;
  void* args[] = {&p, &lo, &hi};
  hipError_t e = hipLaunchCooperativeKernel((void*)mega, dim3(grid_blocks), dim3(256), args, 0, stream);
  if (e != hipSuccess) fprintf(stderr, "cooperative launch failed: %s (grid %d)\n", hipGetErrorString(e), grid_blocks);
#else
  for (int ph = 0; ph < NPH; ++ph) mega<<<grid_blocks, 256, 0, stream>>>(p, ph, ph + 1);
#endif
}
```

```cpp
#include <hip/hip_runtime.h>
#include <hip/hip_cooperative_groups.h>
#include <cstdio>
namespace cg = cooperative_groups;

#ifndef DUP_MASK
#define DUP_MASK 0
#endif
#ifndef SINGLE_LAUNCH
#define SINGLE_LAUNCH 1
#endif

#define DI __device__ __forceinline__
#define HD __device__ __forceinline__
#define SINCOSPI(x, s, c) do { *(s) = __builtin_amdgcn_sinf(0.5f * (x)); *(c) = __builtin_amdgcn_cosf(0.5f * (x)); } while (0)
#define OPAQUE(x) asm volatile("" : "+v"(x))
#ifdef DIAG_NOINLINE
#define ITEMFN __device__ __attribute__((noinline))
#else
#define ITEMFN __device__ __forceinline__
#endif

struct cpx { float x, y; };
HD cpx cmul(cpx a, cpx b) { cpx r; r.x = a.x * b.x - a.y * b.y; r.y = a.x * b.y + a.y * b.x; return r; }
HD cpx cmulc(cpx a, cpx b) { cpx r; r.x = a.x * b.x + a.y * b.y; r.y = a.y * b.x - a.x * b.y; return r; }
HD cpx cadd(cpx a, cpx b) { cpx r; r.x = a.x + b.x; r.y = a.y + b.y; return r; }
HD cpx csub(cpx a, cpx b) { cpx r; r.x = a.x - b.x; r.y = a.y - b.y; return r; }
template <bool INV> HD cpx mulmi(cpx a) { cpx r; if (!INV) { r.x = a.y; r.y = -a.x; } else { r.x = -a.y; r.y = a.x; } return r; }
template <bool INV> HD void dft4(cpx& a0, cpx& a1, cpx& a2, cpx& a3) {
  cpx s02 = cadd(a0, a2), d02 = csub(a0, a2), s13 = cadd(a1, a3), d13 = mulmi<INV>(csub(a1, a3));
  a0 = cadd(s02, s13); a2 = csub(s02, s13); a1 = cadd(d02, d13); a3 = csub(d02, d13);
}
template <bool INV> HD cpx twc(cpx a, float c, float s) {
  cpx r; if (!INV) { r.x = a.x * c + a.y * s; r.y = a.y * c - a.x * s; } else { r.x = a.x * c - a.y * s; r.y = a.y * c + a.x * s; } return r;
}
template <bool INV> HD void dft16(cpx (&v)[16]) {
#pragma unroll
  for (int b = 0; b < 4; ++b) dft4<INV>(v[b], v[4 + b], v[8 + b], v[12 + b]);
  const float C1 = 0.92387953251128674f, S1 = 0.38268343236508977f, R2 = 0.70710678118654752f;
  v[4 * 1 + 1] = twc<INV>(v[4 * 1 + 1], C1, S1);
  v[4 * 2 + 1] = twc<INV>(v[4 * 2 + 1], R2, R2);
  v[4 * 3 + 1] = twc<INV>(v[4 * 3 + 1], S1, C1);
  v[4 * 1 + 2] = twc<INV>(v[4 * 1 + 2], R2, R2);
  v[4 * 2 + 2] = mulmi<INV>(v[4 * 2 + 2]);
  v[4 * 3 + 2] = twc<INV>(v[4 * 3 + 2], -R2, R2);
  v[4 * 1 + 3] = twc<INV>(v[4 * 1 + 3], S1, C1);
  v[4 * 2 + 3] = twc<INV>(v[4 * 2 + 3], -R2, R2);
  v[4 * 3 + 3] = twc<INV>(v[4 * 3 + 3], -C1, -S1);
#pragma unroll
  for (int c = 0; c < 4; ++c) dft4<INV>(v[4 * c + 0], v[4 * c + 1], v[4 * c + 2], v[4 * c + 3]);
#pragma unroll
  for (int c = 0; c < 4; ++c)
#pragma unroll
    for (int d = c + 1; d < 4; ++d) { cpx t = v[4 * c + d]; v[4 * c + d] = v[4 * d + c]; v[4 * d + c] = t; }
}
HD int PADI(int p) { return p + (p >> 4); }
template <bool INV> HD void twiddle16(cpx (&v)[16], float c1, float s1) {
  cpx w[16];
  w[1].x = c1; w[1].y = INV ? s1 : -s1;
  w[2] = cmul(w[1], w[1]); w[3] = cmul(w[2], w[1]); w[4] = cmul(w[2], w[2]);
  w[5] = cmul(w[4], w[1]); w[6] = cmul(w[4], w[2]); w[7] = cmul(w[4], w[3]); w[8] = cmul(w[4], w[4]);
#pragma unroll
  for (int k = 9; k < 16; ++k) w[k] = cmul(w[8], w[k - 8]);
#pragma unroll
  for (int k = 1; k < 16; ++k) v[k] = cmul(v[k], w[k]);
}
template <int S, bool LOAD, bool STORE> HD void fft_fwd_pass(cpx (&v)[16], cpx* buf, int tid) {
  OPAQUE(tid);
  const int n1 = tid & (S - 1), hi = tid / S, base = hi * 16 * S + n1;
  cpx* bp = buf + PADI(base);
  constexpr int STR = S == 1 ? 1 : S + S / 16;
  if (LOAD) {
#pragma unroll
    for (int j = 0; j < 16; ++j) v[j] = bp[STR * j];
  }
  dft16<false>(v);
  if (S > 1) { int n1o = n1; OPAQUE(n1o); float s, c; SINCOSPI(2.0f * (float)n1o / (float)(16 * S), &s, &c); twiddle16<false>(v, c, s); }
  if (STORE) {
#pragma unroll
    for (int j = 0; j < 16; ++j) bp[STR * j] = v[j];
  }
}
template <int S, bool LOAD, bool STORE> HD void fft_inv_pass(cpx (&v)[16], cpx* buf, int tid) {
  OPAQUE(tid);
  const int n1 = tid & (S - 1), hi = tid / S, base = hi * 16 * S + n1;
  cpx* bp = buf + PADI(base);
  constexpr int STR = S == 1 ? 1 : S + S / 16;
  if (LOAD) {
#pragma unroll
    for (int j = 0; j < 16; ++j) v[j] = bp[STR * j];
  }
  if (S > 1) { int n1o = n1; OPAQUE(n1o); float s, c; SINCOSPI(2.0f * (float)n1o / (float)(16 * S), &s, &c); twiddle16<true>(v, c, s); }
  dft16<true>(v);
  if (STORE) {
#pragma unroll
    for (int j = 0; j < 16; ++j) bp[STR * j] = v[j];
  }
}


typedef unsigned short bfr;
using bf16x8 = __attribute__((ext_vector_type(8))) short;
using s16x4 = __attribute__((ext_vector_type(4))) short;
using f32x16 = __attribute__((ext_vector_type(16))) float;
using u32x4 = __attribute__((ext_vector_type(4))) unsigned;
using u32x2 = __attribute__((ext_vector_type(2))) unsigned;
using f32x4 = __attribute__((ext_vector_type(4))) float;
#define SB() __builtin_amdgcn_sched_barrier(0)
#define MFMA(a, b, c) __builtin_amdgcn_mfma_f32_32x32x16_bf16((a), (b), (c), 0, 0, 0)

constexpr int MT = 40960;
constexpr int MP = 8192;
constexpr int NPH = 11;

enum { I_XP = 0, I_XS, I_CK, I_CV, I_C, I_CCTX, I_NORM0G, I_MOD0W, I_MOD0B, I_IN0W, I_QNG, I_KNG, I_RELB, I_OUT0W,
       I_NORM1G, I_MOD1W, I_MOD1B, I_IN1W, I_SCW, I_SCB, I_FW1, I_FB1, I_FFR1, I_FW2, I_FB2, I_FFR2, I_FW3, I_FSKIP, I_OUT1W };

struct Params {
  const float* in[29];
  float* out;
  char* ws;
};

constexpr size_t OFF_W0T = 0;
constexpr size_t OFF_WO0T = 7340032;
constexpr size_t OFF_W1T = 9437184;
constexpr size_t OFF_WO1T = 17825792;
constexpr size_t OFF_MOD = 19922944;
constexpr size_t OFF_CKB = 20144128;
constexpr size_t OFF_CVT = 24338432;
constexpr size_t OFF_HID = 28532736;
constexpr size_t OFF_FSUM = 29646848;
constexpr size_t OFF_F256 = 29663232;
constexpr size_t OFF_F4096 = 33857536;
constexpr size_t OFF_R2 = 100966400;
constexpr size_t OFF_BIG = 184852480;
constexpr size_t OFF_R1 = OFF_BIG;
constexpr size_t OFF_AGT = OFF_BIG + 83886080;
constexpr size_t OFF_Q = OFF_BIG + 125829120;
constexpr size_t OFF_K = OFF_BIG + 167772160;
constexpr size_t OFF_VT = OFF_BIG + 209715200;
constexpr size_t OFF_BGT = OFF_BIG + 251658240;
constexpr size_t OFF_BAR = OFF_BIG + 335544320;
constexpr size_t WS_NEEDED = OFF_BAR + 16384;

constexpr size_t OUT_K = 41943040;
constexpr size_t OUT_V = 46137344;

DI int mytid() { int t = __builtin_amdgcn_workitem_id_x(); OPAQUE(t); return t; }
typedef __bf16 bf16x2_t __attribute__((ext_vector_type(2)));
DI bfr f2bf(float x) { __bf16 v = (__bf16)x; return __builtin_bit_cast(bfr, v); }
DI float bf2f(bfr b) { return __uint_as_float(((unsigned)b) << 16); }
DI unsigned pk2(float a, float b) { bf16x2_t v = {(__bf16)a, (__bf16)b}; return __builtin_bit_cast(unsigned, v); }
DI float siluf(float v) { return v / (1.f + __expf(-v)); }
DI int crow(int i, int h) { return (i & 3) + 8 * (i >> 2) + 4 * h; }
DI int clampi(int v, int lo, int hi) { return v < lo ? lo : (v > hi ? hi : v); }

ITEMFN void p0_mod(const Params& p, char* smem, int item) {
  const int tid = mytid();
  const int layer = item / 96, nb = item % 96;
  float* sl = (float*)smem;
  float* red = sl;
  const float* c = p.in[I_C];
  const float* cc = p.in[I_CCTX];
  for (int idx = tid; idx < 9 * 1024; idx += 256) {
    int ci = idx >> 10, k = idx & 1023;
    float v = ci < 8 ? c[ci * 1024 + k] : cc[k];
    sl[idx] = v / (1.f + expf(-v));
  }
  __syncthreads();
  const float* W = (layer ? p.in[I_MOD1W] : p.in[I_MOD0W]);
  const float* B = (layer ? p.in[I_MOD1B] : p.in[I_MOD0B]);
  const int kg = tid >> 5, col = tid & 31, n = nb * 32 + col;
  float acc[9];
#pragma unroll
  for (int ci = 0; ci < 9; ++ci) acc[ci] = 0.f;
#pragma unroll 4
  for (int k = kg * 128; k < kg * 128 + 128; ++k) {
    float w = W[(size_t)k * 3072 + n];
#pragma unroll
    for (int ci = 0; ci < 9; ++ci) acc[ci] += sl[ci * 1024 + k] * w;
  }
  __syncthreads();
#pragma unroll
  for (int ci = 0; ci < 9; ++ci) red[(kg * 9 + ci) * 32 + col] = acc[ci];
  __syncthreads();
  float* mod = (float*)(p.ws + OFF_MOD) + layer * 9 * 3072;
  for (int idx = tid; idx < 288; idx += 256) {
    int ci = idx >> 5, cl = idx & 31;
    float s = 0.f;
    for (int k2 = 0; k2 < 8; ++k2) s += red[(k2 * 9 + ci) * 32 + cl];
    mod[ci * 3072 + nb * 32 + cl] = s + B[nb * 32 + cl];
  }
  __syncthreads();
}

ITEMFN void p0_fold(const Params& p, char* smem, int item) {
  const int tid = mytid();
  const int g = item >> 5, k0 = (item & 31) * 32;
  float* a = (float*)smem;
  float* ct = a + 32 * 128;
  float* st = ct + 128;
  const float* W = p.in[I_IN0W];
  for (int idx = tid; idx < 32 * 128; idx += 256) {
    int kk = idx >> 7, cc = idx & 127;
    a[idx] = W[(size_t)(k0 + kk) * 3072 + g * 128 + cc];
  }
  if (tid < 128) { float s, c; sincospif(2.f * (float)tid / 128.f, &s, &c); ct[tid] = c; st[tid] = s; }
  __syncthreads();
  const int q = tid & 127, kh = tid >> 7;
  const int k2 = q <= 64 ? q : q - 64;
  float acc[16];
#pragma unroll
  for (int kk = 0; kk < 16; ++kk) acc[kk] = 0.f;
#pragma unroll 1
  for (int cc = 0; cc < 128; ++cc) {
    int idx = (k2 * cc) & 127;
    float t = q <= 64 ? ct[idx] : -st[idx];
#pragma unroll
    for (int kk = 0; kk < 16; ++kk) acc[kk] += a[(kh * 16 + kk) * 128 + cc] * t;
  }
  bfr* dst = (bfr*)(p.ws + OFF_W0T) + (size_t)(g * 128 + q) * 1024 + k0 + kh * 16;
#pragma unroll
  for (int qq = 0; qq < 2; ++qq) {
    u32x4 v;
    v.x = pk2(acc[8 * qq + 0], acc[8 * qq + 1]); v.y = pk2(acc[8 * qq + 2], acc[8 * qq + 3]);
    v.z = pk2(acc[8 * qq + 4], acc[8 * qq + 5]); v.w = pk2(acc[8 * qq + 6], acc[8 * qq + 7]);
    *(u32x4*)(dst + 8 * qq) = v;
  }
  __syncthreads();
}

ITEMFN void p0_transpose(const Params& p, char* smem, int item) {
  const int tid = mytid();
  int nt = item >> 4;
  const int k0 = (item & 15) * 64;
  const float* src; int ld, coloff; bfr* dst;
  if (nt < 40) { src = p.in[I_IN0W]; ld = 3072; coloff = 512 + nt * 64; dst = (bfr*)(p.ws + OFF_W0T) + (size_t)(512 + nt * 64) * 1024; }
  else if (nt < 56) { nt -= 40; src = p.in[I_OUT0W]; ld = 1024; coloff = nt * 64; dst = (bfr*)(p.ws + OFF_WO0T) + (size_t)(nt * 64) * 1024; }
  else if (nt < 120) { nt -= 56; src = p.in[I_IN1W]; ld = 4096; coloff = nt * 64; dst = (bfr*)(p.ws + OFF_W1T) + (size_t)(nt * 64) * 1024; }
  else { nt -= 120; src = p.in[I_OUT1W]; ld = 1024; coloff = nt * 64; dst = (bfr*)(p.ws + OFF_WO1T) + (size_t)(nt * 64) * 1024; }
  float* t = (float*)smem;
#pragma unroll
  for (int i = 0; i < 4; ++i) {
    int idx = tid + 256 * i, kk = idx >> 4, c4 = idx & 15;
    f32x4 v = *(const f32x4*)(src + (size_t)(k0 + kk) * ld + coloff + 4 * c4);
    t[kk * 65 + 4 * c4 + 0] = v.x; t[kk * 65 + 4 * c4 + 1] = v.y; t[kk * 65 + 4 * c4 + 2] = v.z; t[kk * 65 + 4 * c4 + 3] = v.w;
  }
  __syncthreads();
#pragma unroll
  for (int i = 0; i < 2; ++i) {
    int idx = tid + 256 * i, nn = idx >> 3, kc = idx & 7;
    float f[8];
#pragma unroll
    for (int e = 0; e < 8; ++e) f[e] = t[(8 * kc + e) * 65 + nn];
    u32x4 v; v.x = pk2(f[0], f[1]); v.y = pk2(f[2], f[3]); v.z = pk2(f[4], f[5]); v.w = pk2(f[6], f[7]);
    *(u32x4*)(dst + (size_t)nn * 1024 + k0 + 8 * kc) = v;
  }
  __syncthreads();
}

ITEMFN void p0_cache(const Params& p, char* smem, int item) {
  const int tid = mytid();
  const int b = item >> 6, hd = (item >> 3) & 7, p0 = (item & 7) * 64;
  const float* ck = p.in[I_CK];
  const float* cv = p.in[I_CV];
  bfr* dk = (bfr*)(p.ws + OFF_CKB);
  bfr* dv = (bfr*)(p.ws + OFF_CVT);
  float* t = (float*)smem;
#pragma unroll
  for (int i = 0; i < 4; ++i) {
    int idx = tid + 256 * i, pp = idx >> 4, c4 = idx & 15;
    size_t so = ((size_t)(b * 512 + p0 + pp) * 8 + hd) * 64 + 4 * c4;
    f32x4 kv = *(const f32x4*)(ck + so);
    u32x2 o; o.x = pk2(kv.x, kv.y); o.y = pk2(kv.z, kv.w);
    *(u32x2*)(dk + ((size_t)(b * 8 + hd) * 512 + p0 + pp) * 64 + 4 * c4) = o;
    f32x4 v = *(const f32x4*)(cv + so);
    t[pp * 65 + 4 * c4 + 0] = v.x; t[pp * 65 + 4 * c4 + 1] = v.y; t[pp * 65 + 4 * c4 + 2] = v.z; t[pp * 65 + 4 * c4 + 3] = v.w;
  }
  __syncthreads();
#pragma unroll
  for (int i = 0; i < 2; ++i) {
    int idx = tid + 256 * i, dd = idx >> 3, pc = idx & 7;
    float f[8];
#pragma unroll
    for (int e = 0; e < 8; ++e) f[e] = t[(8 * pc + e) * 65 + dd];
    u32x4 v; v.x = pk2(f[0], f[1]); v.y = pk2(f[2], f[3]); v.z = pk2(f[4], f[5]); v.w = pk2(f[6], f[7]);
    *(u32x4*)(dv + ((size_t)(b * 8 + hd) * 64 + dd) * 512 + p0 + 8 * pc) = v;
  }
  __syncthreads();
}

ITEMFN void p0_hid(const Params& p, char* smem, int item) {
  const int tid = mytid();
  const int variant = item >= 16 ? 1 : 0;
  const int tb = variant ? item - 16 : item;
  const int L = variant ? 4096 : 256;
  float* w1s = (float*)smem;
  float* w2s = w1s + 2112;
  float* z = w2s + 4096;
  float* h1 = z + 144;
  for (int idx = tid; idx < 2112; idx += 256) w1s[idx] = p.in[I_FW1][idx];
  for (int idx = tid; idx < 4096; idx += 256) w2s[idx] = p.in[I_FW2][idx];
  const int tt = tid >> 6, j = tid & 63;
  const float b1 = p.in[I_FB1][j], f1 = p.in[I_FFR1][j], b2 = p.in[I_FB2][j], f2 = p.in[I_FFR2][j];
  float* hid = (float*)(p.ws + OFF_HID) + (variant ? 256 * 64 : 0);
  __syncthreads();
#pragma unroll 1
  for (int rd = 0; rd < 4; ++rd) {
    const int t = tb * 16 + rd * 4 + tt;
    if (j < 33) {
      float val;
      if (j == 0) val = (float)t / (float)(L - 1);
      else {
        int b = (j - 1) & 15;
        float f = 1e-4f + (float)b * ((15.0f - 1e-4f) / 15.0f);
        float w = (6.283185307179586f * (float)t) / (float)L;
        float a = f * w;
        val = j <= 16 ? cosf(a) : -sinf(a);
      }
      z[tt * 36 + j] = val;
    }
    __syncthreads();
    float pre = b1;
#pragma unroll
    for (int i = 0; i < 33; ++i) pre += z[tt * 36 + i] * w1s[i * 64 + j];
    h1[tt * 64 + j] = sinf(f1 * pre);
    __syncthreads();
    float pre2 = b2;
#pragma unroll 16
    for (int i = 0; i < 64; ++i) pre2 += h1[tt * 64 + i] * w2s[i * 64 + j];
    hid[(size_t)j * L + t] = sinf(f2 * pre2);
    __syncthreads();
  }
}

ITEMFN void norm_item(const Params& p, int item, int layer) {
  const int tid = mytid(), lane = tid & 63, wave = tid >> 6;
  const float* g = (layer ? p.in[I_NORM1G] : p.in[I_NORM0G]);
  const float* mod = (const float*)(p.ws + OFF_MOD) + layer * 9 * 3072;
  bfr* dst = (bfr*)(p.ws + (layer ? OFF_R2 : OFF_R1));
  for (int rr = 0; rr < 4; ++rr) {
    const int m = item * 16 + wave * 4 + rr;
    const float* xr = layer ? (const float*)p.out + (size_t)m * 1024
                            : (m < MP ? p.in[I_XP] + (size_t)m * 1024 : p.in[I_XS] + (size_t)(m - MP) * 1024);
    const int ci = m < MP ? 8 : (m - MP) >> 12;
    f32x4 v[4];
    float ss = 0.f;
#pragma unroll
    for (int i = 0; i < 4; ++i) {
      v[i] = *(const f32x4*)(xr + lane * 4 + 256 * i);
      ss += v[i].x * v[i].x + v[i].y * v[i].y + v[i].z * v[i].z + v[i].w * v[i].w;
    }
#pragma unroll
    for (int o = 32; o >= 1; o >>= 1) ss += __shfl_xor(ss, o);
    const float rs = rsqrtf(ss * (1.f / 1024.f) + 1e-6f);
#pragma unroll
    for (int i = 0; i < 4; ++i) {
      const int col = lane * 4 + 256 * i;
      f32x4 g4 = *(const f32x4*)(g + col);
      f32x4 sh = *(const f32x4*)(mod + ci * 3072 + col);
      f32x4 sc = *(const f32x4*)(mod + ci * 3072 + 1024 + col);
      float a = v[i].x * rs * g4.x * (1.f + sc.x) + sh.x;
      float b = v[i].y * rs * g4.y * (1.f + sc.y) + sh.y;
      float c = v[i].z * rs * g4.z * (1.f + sc.z) + sh.z;
      float d = v[i].w * rs * g4.w * (1.f + sc.w) + sh.w;
      u32x2 o; o.x = pk2(a, b); o.y = pk2(c, d);
      *(u32x2*)(dst + (size_t)m * 1024 + col) = o;
    }
  }
}

template <int NT>
DI void filt_body(const Params& p, float* wl, float* red, int tid, int variant, int order, int w0) {
  constexpr int L = NT * 256;
  const float* hid = (const float*)(p.ws + OFF_HID) + (variant ? 256 * 64 : 0);
  float* F = (float*)(p.ws + (variant ? OFF_F4096 : OFF_F256));
  float acc[NT][8];
#pragma unroll
  for (int i = 0; i < NT; ++i)
#pragma unroll
    for (int c8 = 0; c8 < 8; ++c8) acc[i][c8] = 0.f;
#pragma unroll 4
  for (int k = 0; k < 64; ++k) {
    float hv[NT];
#pragma unroll
    for (int i = 0; i < NT; ++i) hv[i] = hid[(size_t)k * L + tid + 256 * i];
    const f32x4 wa = *(const f32x4*)(wl + k * 8);
    const f32x4 wb = *(const f32x4*)(wl + k * 8 + 4);
#pragma unroll
    for (int i = 0; i < NT; ++i) {
      acc[i][0] += hv[i] * wa.x; acc[i][1] += hv[i] * wa.y; acc[i][2] += hv[i] * wa.z; acc[i][3] += hv[i] * wa.w;
      acc[i][4] += hv[i] * wb.x; acc[i][5] += hv[i] * wb.y; acc[i][6] += hv[i] * wb.z; acc[i][7] += hv[i] * wb.w;
    }
  }
  const float MIND = -3.0701134573253947f, MAXD = -15.350567286626973f;
  float asum[4] = {0.f, 0.f, 0.f, 0.f};
#pragma unroll
  for (int i = 0; i < NT; ++i) {
    const int t = tid + 256 * i;
    const float tn = (float)t / (float)(L - 1);
#pragma unroll
    for (int wi = 0; wi < 4; ++wi) {
      const float delta = fabsf(MIND + (float)(w0 + wi) * ((MAXD - MIND) / 1023.f));
      const float dec = expf(-tn * delta);
#pragma unroll
      for (int dir = 0; dir < 2; ++dir) {
        const float val = acc[i][dir * 4 + wi] * dec;
        asum[wi] += fabsf(val);
        F[((size_t)(dir * 2 + order) * 1024 + w0 + wi) * L + t] = val;
      }
    }
  }
#pragma unroll
  for (int wi = 0; wi < 4; ++wi) {
#pragma unroll
    for (int o = 32; o >= 1; o >>= 1) asum[wi] += __shfl_xor(asum[wi], o);
  }
  if ((tid & 63) == 0) {
#pragma unroll
    for (int wi = 0; wi < 4; ++wi) red[(tid >> 6) * 4 + wi] = asum[wi];
  }
}

ITEMFN void filt_item(const Params& p, char* smem, int item) {
  const int tid = mytid();
  const int variant = item >> 9, order = (item >> 8) & 1, w0 = (item & 255) * 4;
  float* wl = (float*)smem;
  float* red = wl + 512;
  const float* w3 = p.in[I_FW3];
  for (int idx = tid; idx < 512; idx += 256) {
    int k = idx >> 3, c8 = idx & 7, dir = c8 >> 2, wi = c8 & 3;
    wl[idx] = w3[(size_t)k * 4096 + dir * 2048 + order * 1024 + w0 + wi];
  }
  __syncthreads();
  if (variant) filt_body<16>(p, wl, red, tid, variant, order, w0);
  else filt_body<1>(p, wl, red, tid, variant, order, w0);
  __syncthreads();
  if (tid < 4) {
    float* fsum = (float*)(p.ws + OFF_FSUM);
    fsum[(variant * 2 + order) * 1024 + w0 + tid] = red[tid] + red[4 + tid] + red[8 + tid] + red[12 + tid];
  }
  __syncthreads();
}

DI int swz(int row, int chunk) { return row * 128 + (((chunk ^ (row >> 1) ^ (row >> 4)) & 7) << 4); }

template <bool AT>
DI void g_load(u32x4 (&rx)[4], u32x4 (&rw)[4], const bfr* __restrict__ X, const bfr* __restrict__ W, int m0, int n0, int k0) {
  const int tid = mytid();
#pragma unroll
  for (int i = 0; i < 4; ++i) {
    const int row = (tid >> 3) + 32 * i, c = tid & 7;
    rw[i] = *(const u32x4*)(W + (size_t)(n0 + row) * 1024 + k0 + 8 * c);
    if (!AT) rx[i] = *(const u32x4*)(X + (size_t)(m0 + row) * 1024 + k0 + 8 * c);
  }
  if (AT) {
#pragma unroll
    for (int i = 0; i < 2; ++i) {
      const int idx = tid + 256 * i, mc = idx & 15, kp = idx >> 4;
      rx[2 * i] = *(const u32x4*)(X + (size_t)(k0 + 2 * kp) * MT + m0 + 8 * mc);
      rx[2 * i + 1] = *(const u32x4*)(X + (size_t)(k0 + 2 * kp + 1) * MT + m0 + 8 * mc);
    }
  }
}
template <bool AT>
DI void g_store(const u32x4 (&rx)[4], const u32x4 (&rw)[4], char* Xs, char* Ws) {
  const int tid = mytid();
#pragma unroll
  for (int i = 0; i < 4; ++i) {
    const int row = (tid >> 3) + 32 * i, c = tid & 7;
    *(u32x4*)(Ws + swz(row, c)) = rw[i];
    if (!AT) *(u32x4*)(Xs + swz(row, c)) = rx[i];
  }
  if (AT) {
#pragma unroll
    for (int i = 0; i < 2; ++i) {
      const int idx = tid + 256 * i, mc = idx & 15, kp = idx >> 4;
      const unsigned lo[4] = {rx[2 * i].x, rx[2 * i].y, rx[2 * i].z, rx[2 * i].w};
      const unsigned hi[4] = {rx[2 * i + 1].x, rx[2 * i + 1].y, rx[2 * i + 1].z, rx[2 * i + 1].w};
#pragma unroll
      for (int e = 0; e < 8; ++e) {
        const unsigned a = lo[e >> 1], b = hi[e >> 1];
        const unsigned val = (e & 1) ? ((a >> 16) | (b & 0xffff0000u)) : ((a & 0xffffu) | (b << 16));
        const int row = 8 * mc + e;
        *(unsigned*)(Xs + swz(row, kp >> 2) + (kp & 3) * 4) = val;
      }
    }
  }
}

template <bool AT, bool SWAP>
DI void gemm_main(f32x16 (&acc)[2][2], const bfr* __restrict__ X, const bfr* __restrict__ W, int m0, int n0, char* smem) {
  char* Xs = smem;
  char* Ws = smem + 16384;
  const int tid = mytid(), lane = tid & 63, wave = tid >> 6, r = lane & 31, h = lane >> 5;
  const int wm = wave >> 1, wn = wave & 1;
#pragma unroll
  for (int a = 0; a < 2; ++a)
#pragma unroll
    for (int b = 0; b < 2; ++b)
#pragma unroll
      for (int i = 0; i < 16; ++i) acc[a][b][i] = 0.f;
  u32x4 rx[4], rw[4];
  g_load<AT>(rx, rw, X, W, m0, n0, 0);
  for (int kt = 0; kt < 16; ++kt) {
    __syncthreads();
    g_store<AT>(rx, rw, Xs, Ws);
    __syncthreads();
    if (kt < 15) g_load<AT>(rx, rw, X, W, m0, n0, (kt + 1) * 64);
#pragma unroll
    for (int s = 0; s < 4; ++s) {
      bf16x8 xf[2], wf[2];
#pragma unroll
      for (int t = 0; t < 2; ++t) {
        xf[t] = *(const bf16x8*)(Xs + swz(64 * wm + 32 * t + r, 2 * s + h));
        wf[t] = *(const bf16x8*)(Ws + swz(64 * wn + 32 * t + r, 2 * s + h));
      }
#pragma unroll
      for (int a = 0; a < 2; ++a)
#pragma unroll
        for (int b = 0; b < 2; ++b) {
          if (SWAP) acc[a][b] = MFMA(wf[a], xf[b], acc[a][b]);
          else acc[a][b] = MFMA(xf[a], wf[b], acc[a][b]);
        }
    }
  }
}

DI void gemm_main_big(f32x16 (&acc)[4][2], const bfr* __restrict__ X, const bfr* __restrict__ W, int m0, int n0, char* smem) {
  char* Xs = smem;
  char* Ws = smem + 16384;
  const int tid = mytid(), lane = tid & 63, wave = tid >> 6, r = lane & 31, h = lane >> 5;
  const int wm = wave >> 1, wn = wave & 1;
#pragma unroll
  for (int a = 0; a < 4; ++a)
#pragma unroll
    for (int b = 0; b < 2; ++b)
#pragma unroll
      for (int i = 0; i < 16; ++i) acc[a][b][i] = 0.f;
  u32x4 rx[4], rw[8];
  const int lrow = tid >> 3, lc = tid & 7;
  const bfr* xp = X + (size_t)(m0 + lrow) * 1024 + 8 * lc;
  const bfr* wp = W + (size_t)(n0 + lrow) * 1024 + 8 * lc;
#pragma unroll
  for (int i = 0; i < 4; ++i) rx[i] = *(const u32x4*)(xp + (size_t)(32 * i) * 1024);
#pragma unroll
  for (int i = 0; i < 8; ++i) rw[i] = *(const u32x4*)(wp + (size_t)(32 * i) * 1024);
  for (int kt = 0; kt < 16; ++kt) {
    __syncthreads();
#pragma unroll
    for (int i = 0; i < 4; ++i) *(u32x4*)(Xs + swz(lrow + 32 * i, lc)) = rx[i];
#pragma unroll
    for (int i = 0; i < 8; ++i) *(u32x4*)(Ws + swz(lrow + 32 * i, lc)) = rw[i];
    __syncthreads();
    if (kt < 15) {
#pragma unroll
      for (int i = 0; i < 4; ++i) rx[i] = *(const u32x4*)(xp + (size_t)(32 * i) * 1024 + (kt + 1) * 64);
#pragma unroll
      for (int i = 0; i < 8; ++i) rw[i] = *(const u32x4*)(wp + (size_t)(32 * i) * 1024 + (kt + 1) * 64);
    }
#pragma unroll
    for (int s = 0; s < 4; ++s) {
      bf16x8 xf[2], wf[4];
#pragma unroll
      for (int t = 0; t < 2; ++t) xf[t] = *(const bf16x8*)(Xs + swz(64 * wm + 32 * t + r, 2 * s + h));
#pragma unroll
      for (int t = 0; t < 4; ++t) wf[t] = *(const bf16x8*)(Ws + swz(128 * wn + 32 * t + r, 2 * s + h));
#pragma unroll
      for (int a = 0; a < 4; ++a)
#pragma unroll
        for (int b = 0; b < 2; ++b) acc[a][b] = MFMA(wf[a], xf[b], acc[a][b]);
    }
  }
}

template <bool SILU>
DI void store_T4(const f32x16 (&acc)[4][2], bfr* dst, int nrow0, int mcol0, int r, int h) {
#pragma unroll
  for (int tn = 0; tn < 4; ++tn)
#pragma unroll
    for (int tm = 0; tm < 2; ++tm)
#pragma unroll
      for (int i = 0; i < 16; ++i) {
        float v = acc[tn][tm][i];
        if (SILU) v = siluf(v);
        dst[(size_t)(nrow0 + 32 * tn + crow(i, h)) * MT + mcol0 + 32 * tm + r] = f2bf(v);
      }
}

template <bool SILU>
DI void store_T4_lds(const f32x16 (&acc)[4][2], bfr* dst, int nrow0, int mcol0, char* smem, int wave, int lane) {
  const int r = lane & 31, h = lane >> 5;
  char* reg = smem + wave * 9216;
  __syncthreads();
#pragma unroll
  for (int half = 0; half < 2; ++half) {
#pragma unroll
    for (int t2 = 0; t2 < 2; ++t2)
#pragma unroll
      for (int tm = 0; tm < 2; ++tm)
#pragma unroll
        for (int i = 0; i < 16; ++i) {
          float v = acc[2 * half + t2][tm][i];
          if (SILU) v = siluf(v);
          *(bfr*)(reg + (32 * t2 + crow(i, h)) * 144 + (32 * tm + r) * 2) = f2bf(v);
        }
    __syncthreads();
#pragma unroll
    for (int q = 0; q < 8; ++q) {
      const int idx = lane + 64 * q, row = idx >> 3, ch = idx & 7;
      const u32x4 v = *(const u32x4*)(reg + row * 144 + ch * 16);
      __builtin_nontemporal_store(v, (u32x4*)(dst + (size_t)(nrow0 + 64 * half + row) * MT + mcol0 + 8 * ch));
    }
    __syncthreads();
  }
}

template <bool SILU>
DI void store_T(const f32x16 (&acc)[2][2], bfr* dst, int nrow0, int mcol0, int r, int h) {
#pragma unroll
  for (int tn = 0; tn < 2; ++tn)
#pragma unroll
    for (int tm = 0; tm < 2; ++tm)
#pragma unroll
      for (int i = 0; i < 16; ++i) {
        float v = acc[tn][tm][i];
        if (SILU) v = siluf(v);
        dst[(size_t)(nrow0 + 32 * tn + crow(i, h)) * MT + mcol0 + 32 * tm + r] = f2bf(v);
      }
}

template <int NT, int GN>
DI void tile_map(int lt, int x, int& mt, int& nt) {
  const int grp = lt / (8 * GN), in = lt % (8 * GN);
  const int lmh = grp / (NT / GN), nth = grp % (NT / GN);
  mt = (lmh * 8 + in / GN) * 8 + x;
  nt = nth * GN + in % GN;
}

ITEMFN void inproj0_tile(const Params& p, char* smem, int mt, int nt) {
  const int m0 = mt * 128, n0 = nt * 256;
  f32x16 acc[4][2];
  gemm_main_big(acc, (const bfr*)(p.ws + OFF_R1), (const bfr*)(p.ws + OFF_W0T), m0, n0, smem);
  const int tid = mytid(), lane = tid & 63, wave = tid >> 6, r = lane & 31, h = lane >> 5;
  const int mb = m0 + 64 * (wave >> 1), nb = n0 + 128 * (wave & 1);
  if (n0 < 512) { store_T4_lds<false>(acc, (bfr*)(p.ws + OFF_R2), nb, mb, smem, wave, lane); return; }
  const int region = (n0 - 512) >> 9;
  const int nl = nb - 512 - region * 512;
  if (region == 0) { store_T4_lds<true>(acc, (bfr*)(p.ws + OFF_AGT), nl, mb, smem, wave, lane); return; }
  if (region == 4) { store_T4_lds<true>(acc, (bfr*)(p.ws + OFF_BGT), nl, mb, smem, wave, lane); return; }
  if (region == 3) {
    store_T4_lds<false>(acc, (bfr*)(p.ws + OFF_VT), nl, mb, smem, wave, lane);
    if (m0 < MP) {
      float* ov = p.out + OUT_V;
#pragma unroll
      for (int tn = 0; tn < 4; ++tn)
#pragma unroll
        for (int tm = 0; tm < 2; ++tm)
#pragma unroll
          for (int g4 = 0; g4 < 4; ++g4) {
            f32x4 o; o.x = acc[tn][tm][4 * g4]; o.y = acc[tn][tm][4 * g4 + 1]; o.z = acc[tn][tm][4 * g4 + 2]; o.w = acc[tn][tm][4 * g4 + 3];
            *(f32x4*)(ov + (size_t)(mb + 32 * tm + r) * 512 + nl + 32 * tn + 8 * g4 + 4 * h) = o;
          }
    }
    return;
  }
  const float* gg = (region == 1 ? p.in[I_QNG] : p.in[I_KNG]);
  const float qs = region == 1 ? 0.125f * 1.4426950408889634f : 1.f;
  bfr* dst = (bfr*)(p.ws + (region == 1 ? OFF_Q : OFF_K));
#pragma unroll
  for (int tm = 0; tm < 2; ++tm) {
    const int m = mb + 32 * tm + r;
#pragma unroll
    for (int hh = 0; hh < 2; ++hh) {
      float ss = 0.f;
#pragma unroll
      for (int t2 = 0; t2 < 2; ++t2)
#pragma unroll
        for (int i = 0; i < 16; ++i) ss += acc[2 * hh + t2][tm][i] * acc[2 * hh + t2][tm][i];
      ss += __shfl_xor(ss, 32);
      const float rs = rsqrtf(ss * (1.f / 64.f) + 1e-6f);
#pragma unroll
      for (int t2 = 0; t2 < 2; ++t2)
#pragma unroll
        for (int g4 = 0; g4 < 4; ++g4) {
          const int d0 = 32 * t2 + 8 * g4 + 4 * h;
          f32x4 gv = *(const f32x4*)(gg + d0);
          f32x4 o;
          o.x = acc[2 * hh + t2][tm][4 * g4] * rs * gv.x; o.y = acc[2 * hh + t2][tm][4 * g4 + 1] * rs * gv.y;
          o.z = acc[2 * hh + t2][tm][4 * g4 + 2] * rs * gv.z; o.w = acc[2 * hh + t2][tm][4 * g4 + 3] * rs * gv.w;
          const int col = nl + 64 * hh + d0;
          if (region == 2 && m0 < MP) *(f32x4*)(p.out + OUT_K + (size_t)m * 512 + col) = o;
          u32x2 ob; ob.x = pk2(o.x * qs, o.y * qs); ob.y = pk2(o.z * qs, o.w * qs);
          *(u32x2*)(dst + (size_t)m * 512 + col) = ob;
        }
    }
  }
}

ITEMFN void inproj1_tile(const Params& p, char* smem, int mt, int nt) {
  const int m0 = mt * 128, n0 = nt * 256;
  f32x16 acc[4][2];
  gemm_main_big(acc, (const bfr*)(p.ws + OFF_R2), (const bfr*)(p.ws + OFF_W1T), m0, n0, smem);
  const int tid = mytid(), lane = tid & 63, wave = tid >> 6, r = lane & 31, h = lane >> 5;
  store_T4_lds<false>(acc, (bfr*)(p.ws + OFF_BIG), n0 + 128 * (wave & 1), m0 + 64 * (wave >> 1), smem, wave, lane);
}

ITEMFN void outproj_tile(const Params& p, char* smem, int mt, int nt, int layer) {
  const int m0 = mt * 128, n0 = nt * 128;
  f32x16 acc[2][2];
  gemm_main<false, false>(acc, (const bfr*)(p.ws + (layer ? OFF_BIG : OFF_R2)), (const bfr*)(p.ws + (layer ? OFF_WO1T : OFF_WO0T)), m0, n0, smem);
  const int tid = mytid(), lane = tid & 63, wave = tid >> 6, r = lane & 31, h = lane >> 5;
  const int mb = m0 + 64 * (wave >> 1), nb = n0 + 64 * (wave & 1);
  const float* mod = (const float*)(p.ws + OFF_MOD) + layer * 9 * 3072;
  const int ci = m0 < MP ? 8 : (m0 - MP) >> 12;
#pragma unroll
  for (int tm = 0; tm < 2; ++tm)
#pragma unroll
    for (int tn = 0; tn < 2; ++tn) {
      const int n = nb + 32 * tn + r;
      const float gate = mod[ci * 3072 + 2048 + n];
#pragma unroll
      for (int i = 0; i < 16; ++i) {
        const int m = mb + 32 * tm + crow(i, h);
        float xin;
        if (layer) xin = __builtin_nontemporal_load(p.out + (size_t)m * 1024 + n);
        else xin = m < MP ? __builtin_nontemporal_load(p.in[I_XP] + (size_t)m * 1024 + n) : __builtin_nontemporal_load(p.in[I_XS] + (size_t)(m - MP) * 1024 + n);
        const float res = xin + gate * acc[tm][tn][i];
        if (layer) __builtin_nontemporal_store(res, p.out + (size_t)m * 1024 + n);
        else p.out[(size_t)m * 1024 + n] = res;
      }
    }
}

ITEMFN void xpose_item(const Params& p, char* smem, int item, int layer) {
  const int tid = mytid();
  const bfr* src = (const bfr*)(p.ws + (layer ? OFF_R2 : OFF_R1));
  bfr* dst = (bfr*)(p.ws + (layer ? OFF_BIG : OFF_R2));
  const int k0 = (item & 15) * 64, m0 = (item >> 4) * 64;
  unsigned* t = (unsigned*)smem;
  {
    const int mc = tid & 7, kp = tid >> 3;
    const u32x4 a = *(const u32x4*)(src + (size_t)(k0 + 2 * kp) * MT + m0 + 8 * mc);
    const u32x4 b = *(const u32x4*)(src + (size_t)(k0 + 2 * kp + 1) * MT + m0 + 8 * mc);
    const unsigned lo[4] = {a.x, a.y, a.z, a.w};
    const unsigned hi[4] = {b.x, b.y, b.z, b.w};
#pragma unroll
    for (int e = 0; e < 8; ++e) {
      const unsigned x = lo[e >> 1], y = hi[e >> 1];
      const unsigned val = (e & 1) ? ((x >> 16) | (y & 0xffff0000u)) : ((x & 0xffffu) | (y << 16));
      t[(8 * mc + e) * 33 + kp] = val;
    }
  }
  __syncthreads();
#pragma unroll
  for (int i = 0; i < 2; ++i) {
    const int idx = tid + 256 * i, c = idx & 7, m = idx >> 3;
    u32x4 v;
    v.x = t[m * 33 + 4 * c + 0]; v.y = t[m * 33 + 4 * c + 1]; v.z = t[m * 33 + 4 * c + 2]; v.w = t[m * 33 + 4 * c + 3];
    *(u32x4*)(dst + (size_t)(m0 + m) * 1024 + k0 + 8 * c) = v;
  }
  __syncthreads();
}

struct AttnState { f32x16 o[2]; float mrun, lrun; };

DI void kv_gload(u32x4 (&kr)[2], u32x4 (&vr)[2], const bfr* kptr, size_t kstride, const bfr* vptr, size_t vstride, int tid) {
#pragma unroll
  for (int i = 0; i < 2; ++i) {
    const int idx = tid + 256 * i, row = idx >> 3, c = idx & 7;
    kr[i] = *(const u32x4*)(kptr + (size_t)row * kstride + 8 * c);
    vr[i] = *(const u32x4*)(vptr + (size_t)row * vstride + 8 * c);
  }
}
DI void kv_lstore(const u32x4 (&kr)[2], const u32x4 (&vr)[2], char* Ks, char* Vs, int tid) {
#pragma unroll
  for (int i = 0; i < 2; ++i) {
    const int idx = tid + 256 * i, row = idx >> 3, c = idx & 7;
    *(u32x4*)(Ks + row * 144 + c * 16) = kr[i];
    *(u32x4*)(Vs + row * 144 + c * 16) = vr[i];
  }
}

template <bool LOCAL>
DI void attn_chunk(AttnState& st, const bf16x8 (&qf)[4], const char* Ks, const char* Vs, int r, int h,
                   const float* brow, int qc, int cs) {
#pragma unroll
  for (int kt = 0; kt < 2; ++kt) {
    f32x16 s;
#pragma unroll
    for (int i = 0; i < 16; ++i) s[i] = 0.f;
#pragma unroll
    for (int sd = 0; sd < 4; ++sd) {
      bf16x8 kf = *(const bf16x8*)(Ks + (kt * 32 + r) * 144 + (16 * sd + 8 * h) * 2);
      s = MFMA(kf, qf[sd], s);
    }
    if (LOCAL) {
#pragma unroll
      for (int i = 0; i < 16; ++i) {
        const int kc = kt * 32 + crow(i, h);
        const bool valid = (kc >= cs) && (kc < cs + 16);
        const int bi = clampi(kc - qc + 15, 0, 30);
        s[i] = valid ? s[i] + brow[bi] : -INFINITY;
      }
    }
    float mx = s[0];
#pragma unroll
    for (int i = 1; i < 16; ++i) mx = fmaxf(mx, s[i]);
    mx = fmaxf(mx, __shfl_xor(mx, 32));
    if (__builtin_amdgcn_ballot_w64(mx - st.mrun > 8.0f) != 0ull) {
      const float mnew = fmaxf(st.mrun, mx);
      const float alpha = __builtin_amdgcn_exp2f(st.mrun - mnew);
      st.lrun *= alpha;
#pragma unroll
      for (int td = 0; td < 2; ++td)
#pragma unroll
        for (int i = 0; i < 16; ++i) st.o[td][i] *= alpha;
      st.mrun = mnew;
    }
    float ps = 0.f;
#pragma unroll
    for (int i = 0; i < 16; ++i) { s[i] = __builtin_amdgcn_exp2f(s[i] - st.mrun); ps += s[i]; }
    st.lrun += ps;
#pragma unroll
    for (int sp = 0; sp < 2; ++sp) {
      bf16x8 pf;
#pragma unroll
      for (int j = 0; j < 8; ++j) pf[j] = (short)f2bf(s[8 * sp + j]);
#pragma unroll
      for (int td = 0; td < 2; ++td) {
        const char* vp = Vs + (32 * td + r) * 144 + (kt * 32 + 16 * sp + 4 * h) * 2;
        s16x4 lo = *(const s16x4*)vp;
        s16x4 hi = *(const s16x4*)(vp + 16);
        bf16x8 vf;
        vf[0] = lo[0]; vf[1] = lo[1]; vf[2] = lo[2]; vf[3] = lo[3];
        vf[4] = hi[0]; vf[5] = hi[1]; vf[6] = hi[2]; vf[7] = hi[3];
        st.o[td] = MFMA(vf, pf, st.o[td]);
      }
    }
  }
}

DI void attn_finish(const Params& p, AttnState& st, int hd, size_t m, int h) {
  const float l = st.lrun + __shfl_xor(st.lrun, 32);
  const float inv = 1.f / l;
  const bfr* bg = (const bfr*)(p.ws + OFF_BGT);
  bfr* dst = (bfr*)(p.ws + OFF_R1);
#pragma unroll
  for (int td = 0; td < 2; ++td)
#pragma unroll
    for (int i = 0; i < 16; ++i) {
      const int d = 32 * td + crow(i, h);
      const float g = bf2f(bg[(size_t)(hd * 64 + d) * MT + m]);
      dst[(size_t)(512 + hd * 64 + d) * MT + m] = f2bf(st.o[td][i] * inv * g);
    }
}

DI void attn_init(AttnState& st) {
#pragma unroll
  for (int td = 0; td < 2; ++td)
#pragma unroll
    for (int i = 0; i < 16; ++i) st.o[td][i] = 0.f;
  st.mrun = -INFINITY;
  st.lrun = 0.f;
}

ITEMFN void attn_na_item(const Params& p, char* smem, int item) {
  const int tid = mytid(), lane = tid & 63, wave = tid >> 6, r = lane & 31, h = lane >> 5;
  const int b = item >> 8, hd = (item >> 5) & 7, rp = item & 31;
  float* bias = (float*)(smem + 36864);
  const size_t mbase = MP + (size_t)b * 4096;
  const int r0 = 2 * rp, qr = r0 + (wave >> 1), c0 = 32 * (wave & 1);
  const int kr0 = clampi(r0 - 4, 0, 56), kr_end = clampi(r0 - 3, 0, 56) + 8;
  const int rsw = clampi(qr - 4, 0, 56);
  const int nch = 8 + (kr_end - kr0);
  __syncthreads();
  for (int idx = tid; idx < 465; idx += 256) bias[idx] = p.in[I_RELB][hd * 465 + idx] * 1.4426950408889634f;
  const size_t mq = mbase + qr * 64 + c0 + r;
  const bfr* qp = (const bfr*)(p.ws + OFF_Q) + mq * 512 + hd * 64;
  bf16x8 qf[4];
#pragma unroll
  for (int sd = 0; sd < 4; ++sd) qf[sd] = *(const bf16x8*)(qp + 16 * sd + 8 * h);
  AttnState st;
  attn_init(st);
  const bfr* ckb = (const bfr*)(p.ws + OFF_CKB) + (size_t)(b * 8 + hd) * 512 * 64;
  const bfr* cvt = (const bfr*)(p.ws + OFF_CVT) + (size_t)(b * 8 + hd) * 64 * 512;
  const bfr* kb = (const bfr*)(p.ws + OFF_K) + mbase * 512 + hd * 64;
  const bfr* vt = (const bfr*)(p.ws + OFF_VT) + (size_t)(hd * 64) * MT + mbase;
  const int qc = c0 + r, cs = clampi(qc - 8, 0, 48);
  u32x4 kreg[2], vreg[2];
  kv_gload(kreg, vreg, ckb, 64, cvt, 512, tid);
  kv_lstore(kreg, vreg, smem, smem + 9216, tid);
  __syncthreads();
#pragma unroll 1
  for (int c = 0; c < nch; ++c) {
    char* Ks = smem + (c & 1) * 18432;
    char* Vs = Ks + 9216;
    if (c + 1 < nch) {
      const int cn = c + 1;
      if (cn < 8) kv_gload(kreg, vreg, ckb + (size_t)cn * 64 * 64, 64, cvt + cn * 64, 512, tid);
      else { const int kr = kr0 + cn - 8; kv_gload(kreg, vreg, kb + (size_t)kr * 64 * 512, 512, vt + kr * 64, MT, tid); }
    }
    if (c < 8) attn_chunk<false>(st, qf, Ks, Vs, r, h, nullptr, 0, 0);
    else {
      const int kr = kr0 + c - 8;
      if (kr >= rsw && kr < rsw + 8) attn_chunk<true>(st, qf, Ks, Vs, r, h, bias + (kr - qr + 7) * 31, qc, cs);
    }
    if (c + 1 < nch) kv_lstore(kreg, vreg, smem + ((c + 1) & 1) * 18432, smem + ((c + 1) & 1) * 18432 + 9216, tid);
    __syncthreads();
  }
  attn_finish(p, st, hd, mq, h);
}

ITEMFN void attn_ctx_item(const Params& p, char* smem, int item) {
  const int tid = mytid(), lane = tid & 63, wave = tid >> 6, r = lane & 31, h = lane >> 5;
  const int b = item >> 4, hd = (item >> 1) & 7, qh = item & 1;
  const size_t mbase = (size_t)b * 256;
  const size_t mq = mbase + qh * 128 + wave * 32 + r;
  const bfr* qp = (const bfr*)(p.ws + OFF_Q) + mq * 512 + hd * 64;
  bf16x8 qf[4];
#pragma unroll
  for (int sd = 0; sd < 4; ++sd) qf[sd] = *(const bf16x8*)(qp + 16 * sd + 8 * h);
  AttnState st;
  attn_init(st);
  const bfr* kb = (const bfr*)(p.ws + OFF_K) + mbase * 512 + hd * 64;
  const bfr* vt = (const bfr*)(p.ws + OFF_VT) + (size_t)(hd * 64) * MT + mbase;
  u32x4 kreg[2], vreg[2];
  __syncthreads();
  kv_gload(kreg, vreg, kb, 512, vt, MT, tid);
  kv_lstore(kreg, vreg, smem, smem + 9216, tid);
  __syncthreads();
#pragma unroll 1
  for (int c = 0; c < 4; ++c) {
    char* Ks = smem + (c & 1) * 18432;
    char* Vs = Ks + 9216;
    if (c + 1 < 4) kv_gload(kreg, vreg, kb + (size_t)(c + 1) * 64 * 512, 512, vt + (c + 1) * 64, MT, tid);
    attn_chunk<false>(st, qf, Ks, Vs, r, h, nullptr, 0, 0);
    if (c + 1 < 4) kv_lstore(kreg, vreg, smem + ((c + 1) & 1) * 18432, smem + ((c + 1) & 1) * 18432 + 9216, tid);
    __syncthreads();
  }
  attn_finish(p, st, hd, mq, h);
}

DI void fft_fwd(cpx (&v)[16], cpx* buf, int tid) {
  __syncthreads();
  fft_fwd_pass<256, false, true>(v, buf, tid);
  __syncthreads();
  fft_fwd_pass<16, true, true>(v, buf, tid);
  __syncthreads();
  fft_fwd_pass<1, true, false>(v, buf, tid);
}
DI void fft_inv(cpx (&v)[16], cpx* buf, int tid) {
  __syncthreads();
  fft_inv_pass<1, false, true>(v, buf, tid);
  __syncthreads();
  fft_inv_pass<16, true, true>(v, buf, tid);
  __syncthreads();
  fft_inv_pass<256, true, false>(v, buf, tid);
}

DI void fft_fwd_lds(cpx (&v)[16], cpx* buf, int tid) {
  fft_fwd_pass<256, true, true>(v, buf, tid);
  __syncthreads();
  fft_fwd_pass<16, true, true>(v, buf, tid);
  __syncthreads();
  fft_fwd_pass<1, true, false>(v, buf, tid);
}
DI void fft_inv_lds(cpx (&v)[16], cpx* buf, int tid) {
  __syncthreads();
  fft_inv_pass<1, false, true>(v, buf, tid);
  __syncthreads();
  fft_inv_pass<16, true, true>(v, buf, tid);
  __syncthreads();
  fft_inv_pass<256, true, true>(v, buf, tid);
}

ITEMFN void fnet_item(const Params& p, char* smem, int item, bool prompt) {
  const int tid = mytid();
  cpx* buf = (cpx*)smem;
  float* rb = (float*)smem;
  const int sb = item / 260, rem = item - sb * 260, g = rem / 65, k2 = rem - g * 65;
  const size_t mbase = prompt ? (size_t)sb * 4096 : MP + (size_t)sb * 4096;
  const bool has_im = (k2 != 0) && (k2 != 64);
  const bfr* re = (const bfr*)(p.ws + OFF_R2) + (size_t)(g * 128 + k2) * MT + mbase;
  const bfr* im = (const bfr*)(p.ws + OFF_R2) + (size_t)(g * 128 + 64 + (has_im ? k2 : 1)) * MT + mbase;
  cpx v[16];
  float scale;
  if (!prompt) {
#pragma unroll
    for (int jj = 0; jj < 16; ++jj) { v[jj].x = bf2f(re[tid + 256 * jj]); v[jj].y = has_im ? bf2f(im[tid + 256 * jj]) : 0.f; }
    fft_fwd(v, buf, tid);
    __syncthreads();
    scale = 0.0013810679320049757f;
#pragma unroll
    for (int k = 0; k < 16; ++k) { const int idx = k * 256 + (tid & 15) * 16 + (tid >> 4); rb[idx + (idx >> 4)] = v[k].x * scale; }
  } else {
    const int base = (tid >> 4) * 256 + (tid & 15);
#pragma unroll
    for (int jj = 0; jj < 16; ++jj) { v[jj].x = bf2f(re[base + 16 * jj]); v[jj].y = has_im ? bf2f(im[base + 16 * jj]) : 0.f; }
    __syncthreads();
    fft_fwd_pass<16, false, true>(v, buf, tid);
    __syncthreads();
    fft_fwd_pass<1, true, false>(v, buf, tid);
    __syncthreads();
    scale = 0.005524271728019903f;
#pragma unroll
    for (int k = 0; k < 16; ++k) { const int idx = (tid >> 4) * 256 + k * 16 + (tid & 15); rb[idx + (idx >> 4)] = v[k].x * scale; }
  }
  __syncthreads();
  const int lmask = prompt ? 255 : 4095;
  {
    const int j1 = g * 128 + k2;
    const bfr* ag = (const bfr*)(p.ws + OFF_AGT) + (size_t)j1 * MT + mbase;
    bfr* dst = (bfr*)(p.ws + OFF_R1) + (size_t)j1 * MT + mbase;
#pragma unroll
    for (int i = 0; i < 2; ++i) {
      const int q0 = 8 * (tid + 256 * i);
      u32x4 a = *(const u32x4*)(ag + q0);
      const unsigned au[4] = {a.x, a.y, a.z, a.w};
      float f[8];
#pragma unroll
      for (int e = 0; e < 8; ++e) {
        const float gv = (e & 1) ? __uint_as_float(au[e >> 1] & 0xffff0000u) : __uint_as_float(au[e >> 1] << 16);
        f[e] = rb[q0 + (q0 >> 4) + e] * gv;
      }
      u32x4 o; o.x = pk2(f[0], f[1]); o.y = pk2(f[2], f[3]); o.z = pk2(f[4], f[5]); o.w = pk2(f[6], f[7]);
      *(u32x4*)(dst + q0) = o;
    }
  }
  if (has_im) {
    const int j2 = g * 128 + 128 - k2;
    const bfr* ag = (const bfr*)(p.ws + OFF_AGT) + (size_t)j2 * MT + mbase;
    bfr* dst = (bfr*)(p.ws + OFF_R1) + (size_t)j2 * MT + mbase;
#pragma unroll
    for (int i = 0; i < 2; ++i) {
      const int q0 = 8 * (tid + 256 * i);
      u32x4 a = *(const u32x4*)(ag + q0);
      const unsigned au[4] = {a.x, a.y, a.z, a.w};
      float f[8];
#pragma unroll
      for (int e = 0; e < 8; ++e) {
        const float gv = (e & 1) ? __uint_as_float(au[e >> 1] & 0xffff0000u) : __uint_as_float(au[e >> 1] << 16);
        const int k1 = q0 + e;
        const int src = (k1 & ~lmask) | ((lmask + 1 - (k1 & lmask)) & lmask);
        f[e] = rb[src + (src >> 4)] * gv;
      }
      u32x4 o; o.x = pk2(f[0], f[1]); o.y = pk2(f[2], f[3]); o.z = pk2(f[4], f[5]); o.w = pk2(f[6], f[7]);
      *(u32x4*)(dst + q0) = o;
    }
  }
  __syncthreads();
}

DI float conv3(const bfr* row, int n, int L, float w0, float w1, float w2, float bias) {
  const float a = n > 0 ? bf2f(row[n - 1]) : 0.f;
  const float b = bf2f(row[n]);
  const float c = n < L - 1 ? bf2f(row[n + 1]) : 0.f;
  return a * w0 + b * w1 + c * w2 + bias;
}

DI void stage_rows(bfr* l0, bfr* l1, const bfr* g0, const bfr* g1, int tid) {
#pragma unroll
  for (int i = 0; i < 2; ++i) {
    const int ch = tid + 256 * i;
    const u32x4 a = *(const u32x4*)(g0 + 8 * ch);
    const u32x4 b = *(const u32x4*)(g1 + 8 * ch);
    *(u32x4*)(l0 + 8 * ch) = a;
    *(u32x4*)(l1 + 8 * ch) = b;
  }
}
DI float conv3l(const bfr* row, int n, float w0, float w1, float w2, float bias) {
  const float a = bf2f(row[n > 0 ? n - 1 : 0]);
  const float b = bf2f(row[n]);
  const float c = bf2f(row[n < 4095 ? n + 1 : 4095]);
  return (n > 0 ? a : 0.f) * w0 + b * w1 + (n < 4095 ? c : 0.f) * w2 + bias;
}

ITEMFN void hyena_sample_item(const Params& p, char* smem, int c) {
  const int tid = mytid();
  cpx* buf = (cpx*)smem;
  bfr* raw0 = (bfr*)smem;
  bfr* raw1 = (bfr*)(smem + 8192);
  bfr* raw2 = (bfr*)(smem + 16384);
  bfr* raw3 = (bfr*)(smem + 24576);
  const float* scw = p.in[I_SCW];
  const float* scb = p.in[I_SCB];
  bfr* proj = (bfr*)(p.ws + OFF_BIG);
  bfr* P0 = proj + (size_t)c * MT + MP;
  bfr* P1 = proj + (size_t)(1024 + c) * MT + MP;
  const bfr* P2 = proj + (size_t)(2048 + c) * MT + MP;
  const bfr* PG = proj + (size_t)(3072 + c) * MT + MP;
  bfr* dst = (bfr*)(p.ws + OFF_R2) + (size_t)c * MT + MP;
  const float* fsum = (const float*)(p.ws + OFF_FSUM) + 2 * 1024;
  const float* F = (const float*)(p.ws + OFF_F4096);
#pragma unroll 1
  for (int order = 0; order < 2; ++order) {
    const float* hf = F + ((size_t)(0 * 2 + order) * 1024 + c) * 4096;
    const float* hb = F + ((size_t)(1 * 2 + order) * 1024 + c) * 4096;
    const float skip = p.in[I_FSKIP][order * 1024 + c];
    const int col1 = (order + 1) * 1024 + c;
    const float a0 = scw[c], a1 = scw[3072 + c], a2 = scw[6144 + c], ab = scb[c];
    const float m0 = scw[col1], m1 = scw[3072 + col1], m2 = scw[6144 + col1], mb = scb[col1];
    const bfr* PM = order == 0 ? P1 : P2;
    unsigned* ysc = order == 0 ? (unsigned*)dst : (unsigned*)P1;
    cpx G[16];
    {
    const float inv = 1.f / (fsum[order * 1024 + c] + 1e-6f);
    int tt = tid; OPAQUE(tt);
#pragma unroll
    for (int j = 0; j < 16; ++j) {
      const unsigned n = (unsigned)tt + 256u * j;
      const float a = hf[n] * inv + (n == 0u ? skip : 0.f);
      const float bq = n >= 1u ? hb[4096u - n] * inv : 0.f;
      G[j].x = a + bq; G[j].y = 0.f;
    }
    }
    fft_fwd(G, buf, tid);
#pragma unroll 1
    for (int pp = 0; pp < 4; ++pp) {
      int tq = tid; OPAQUE(tq);
      const bfr* r0 = P0 + (size_t)(2 * pp) * 4096;
      const bfr* r1 = P0 + (size_t)(2 * pp + 1) * 4096;
      cpx w[16];
      __syncthreads();
      stage_rows(raw0, raw1, r0, r1, tq);
      __syncthreads();
#pragma unroll
      for (int j = 0; j < 16; ++j) {
        const int n = tq + 256 * j;
        if (order == 0) { w[j].x = conv3l(raw0, n, a0, a1, a2, ab); w[j].y = conv3l(raw1, n, a0, a1, a2, ab); }
        else { w[j].x = bf2f(raw0[n]); w[j].y = bf2f(raw1[n]); }
      }
      fft_fwd(w, buf, tq);
#pragma unroll
      for (int k = 0; k < 16; ++k) w[k] = cmul(w[k], G[k]);
      fft_inv(w, buf, tq);
#pragma unroll
      for (int j = 0; j < 16; ++j) ysc[pp * 4096 + tq + 256 * j] = pk2(w[j].x * (1.f / 8192.f), w[j].y * (1.f / 8192.f));
    }
    {
    const float inv = 1.f / (fsum[order * 1024 + c] + 1e-6f);
    int tt = tid; OPAQUE(tt);
#pragma unroll
    for (int j = 0; j < 16; ++j) {
      const unsigned n = (unsigned)tt + 256u * j;
      const float a = hf[n] * inv + (n == 0u ? skip : 0.f);
      const float bq = n >= 1u ? hb[4096u - n] * inv : 0.f;
      float s, cs;
      SINCOSPI((float)n * (1.f / 4096.f), &s, &cs);
      const float d = a - bq;
      G[j].x = d * cs; G[j].y = -d * s;
    }
    }
    fft_fwd(G, buf, tid);
#pragma unroll 1
    for (int pp = 0; pp < 4; ++pp) {
      int tq = tid; OPAQUE(tq);
      bfr* r0 = P0 + (size_t)(2 * pp) * 4096;
      bfr* r1 = P0 + (size_t)(2 * pp + 1) * 4096;
      cpx w[16];
      __syncthreads();
      stage_rows(raw0, raw1, r0, r1, tq);
      __syncthreads();
#pragma unroll
      for (int j = 0; j < 16; ++j) {
        const int n = tq + 256 * j;
        cpx z;
        if (order == 0) { z.x = conv3l(raw0, n, a0, a1, a2, ab); z.y = conv3l(raw1, n, a0, a1, a2, ab); }
        else { z.x = bf2f(raw0[n]); z.y = bf2f(raw1[n]); }
        float s, cs;
        { int no = n; OPAQUE(no); SINCOSPI((float)no * (1.f / 4096.f), &s, &cs); }
        cpx tw; tw.x = cs; tw.y = -s;
        w[j] = cmul(z, tw);
      }
      fft_fwd(w, buf, tq);
#pragma unroll
      for (int k = 0; k < 16; ++k) w[k] = cmul(w[k], G[k]);
      fft_inv(w, buf, tq);
      unsigned ye[16];
#pragma unroll
      for (int j = 0; j < 16; ++j) ye[j] = ysc[pp * 4096 + tq + 256 * j];
      __syncthreads();
      stage_rows(raw0, raw1, PM + (size_t)(2 * pp) * 4096, PM + (size_t)(2 * pp + 1) * 4096, tq);
      if (order == 1) stage_rows(raw2, raw3, PG + (size_t)(2 * pp) * 4096, PG + (size_t)(2 * pp + 1) * 4096, tq);
      __syncthreads();
      bfr* o0 = order == 0 ? r0 : dst + (size_t)(2 * pp) * 4096;
      bfr* o1 = order == 0 ? r1 : dst + (size_t)(2 * pp + 1) * 4096;
#pragma unroll
      for (int j = 0; j < 16; ++j) {
        const int n = tq + 256 * j;
        float s, cs;
        { int no = n; OPAQUE(no); SINCOSPI((float)no * (1.f / 4096.f), &s, &cs); }
        cpx tw; tw.x = cs; tw.y = -s;
        const cpx yo = cmulc(w[j], tw);
        const float yx = __uint_as_float(ye[j] << 16) + yo.x * (1.f / 8192.f);
        const float yy = __uint_as_float(ye[j] & 0xffff0000u) + yo.y * (1.f / 8192.f);
        const float ux = conv3l(raw0, n, m0, m1, m2, mb);
        const float uy = conv3l(raw1, n, m0, m1, m2, mb);
        const float g0 = order == 0 ? 1.f : siluf(bf2f(raw2[n]));
        const float g1 = order == 0 ? 1.f : siluf(bf2f(raw3[n]));
        o0[n] = f2bf(ux * yx * g0);
        o1[n] = f2bf(uy * yy * g1);
      }
    }
    __syncthreads();
  }
}

ITEMFN void hyena_prompt_item(const Params& p, char* smem, int c) {
  const int tid = mytid();
  cpx* buf = (cpx*)smem;
  const float* scw = p.in[I_SCW];
  const float* scb = p.in[I_SCB];
  bfr* proj = (bfr*)(p.ws + OFF_BIG);
  bfr* P0 = proj + (size_t)c * MT;
  const bfr* P1 = proj + (size_t)(1024 + c) * MT;
  const bfr* P2 = proj + (size_t)(2048 + c) * MT;
  const bfr* PG = proj + (size_t)(3072 + c) * MT;
  bfr* dst = (bfr*)(p.ws + OFF_R2) + (size_t)c * MT;
  const float* fsum = (const float*)(p.ws + OFF_FSUM);
  const float* F = (const float*)(p.ws + OFF_F256);
#pragma unroll 1
  for (int order = 0; order < 2; ++order) {
    cpx G[16];
#pragma unroll
    for (int j = 0; j < 16; ++j) { G[j].x = 0.f; G[j].y = 0.f; }
    const float inv = 1.f / (fsum[order * 1024 + c] + 1e-6f);
    G[0].x = F[((size_t)(0 * 2 + order) * 1024 + c) * 256 + tid] * inv;
    if (tid >= 1) G[15].x = F[((size_t)(1 * 2 + order) * 1024 + c) * 256 + 256 - tid] * inv;
    fft_fwd(G, buf, tid);
    const float skip = p.in[I_FSKIP][order * 1024 + c];
    const int col1 = (order + 1) * 1024 + c;
    const float a0 = scw[c], a1 = scw[3072 + c], a2 = scw[6144 + c], ab = scb[c];
    const float m0 = scw[col1], m1 = scw[3072 + col1], m2 = scw[6144 + col1], mb = scb[col1];
    const bfr* PM = order == 0 ? P1 : P2;
#pragma unroll 1
    for (int cc = 0; cc < 2; ++cc) {
      cpx zr[8], w[16];
#pragma unroll
      for (int j = 0; j < 16; ++j) {
        if ((j & 1) == 0) {
          const size_t o0 = (size_t)(16 * cc + (j >> 1)) * 256, o1 = (size_t)(16 * cc + 8 + (j >> 1)) * 256;
          if (order == 0) { zr[j >> 1].x = conv3(P0 + o0, tid, 256, a0, a1, a2, ab); zr[j >> 1].y = conv3(P0 + o1, tid, 256, a0, a1, a2, ab); }
          else { zr[j >> 1].x = bf2f(P0[o0 + tid]); zr[j >> 1].y = bf2f(P0[o1 + tid]); }
          w[j] = zr[j >> 1];
        } else { w[j].x = 0.f; w[j].y = 0.f; }
      }
      fft_fwd(w, buf, tid);
#pragma unroll
      for (int k = 0; k < 16; ++k) w[k] = cmul(w[k], G[k]);
      fft_inv(w, buf, tid);
#pragma unroll
      for (int j = 0; j < 16; j += 2) {
        const size_t o0 = (size_t)(16 * cc + (j >> 1)) * 256, o1 = (size_t)(16 * cc + 8 + (j >> 1)) * 256;
        const float yx = w[j].x * (1.f / 4096.f) + skip * zr[j >> 1].x;
        const float yy = w[j].y * (1.f / 4096.f) + skip * zr[j >> 1].y;
        const float ux = conv3(PM + o0, tid, 256, m0, m1, m2, mb);
        const float uy = conv3(PM + o1, tid, 256, m0, m1, m2, mb);
        if (order == 0) {
          P0[o0 + tid] = f2bf(ux * yx);
          P0[o1 + tid] = f2bf(uy * yy);
        } else {
          const float g0 = siluf(bf2f(PG[o0 + tid]));
          const float g1 = siluf(bf2f(PG[o1 + tid]));
          dst[o0 + tid] = f2bf(ux * yx * g0);
          dst[o1 + tid] = f2bf(uy * yy * g1);
        }
      }
    }
    __syncthreads();
  }
}


DI void p0_light(const Params& p, char* smem, int it) {
  if (it < 320) p0_fold(p, smem, it - 192);
  else if (it < 592) p0_hid(p, smem, it - 320);
  else if (it < 2768) p0_transpose(p, smem, it - 592);
  else p0_cache(p, smem, it - 2768);
}

#define XB_TMO      128
#define XB_XCNT(j)  (256  + 64 * (j))
#define XB_XSUB(j)  (1280 + 64 * (j))
#define XB_XGEN(j)  (2304 + 64 * (j))
#define XB_TOP      3328
#define XB_TOPGEN   3392
#define XCD_BAR_WORDS 3456
#define XB_SPIN_CAP (1u << 18)
#define LAS __attribute__((address_space(3)))
__device__ __forceinline__ unsigned xb_ld(unsigned* p)              { return __hip_atomic_load(p, __ATOMIC_RELAXED, __HIP_MEMORY_SCOPE_AGENT); }
__device__ __forceinline__ unsigned xb_add(unsigned* p, unsigned v) { return __hip_atomic_fetch_add(p, v, __ATOMIC_RELAXED, __HIP_MEMORY_SCOPE_AGENT); }
__device__ __forceinline__ unsigned xb_xcc_id() { return (unsigned)__builtin_amdgcn_s_getreg((3 << 11) | 20) & 0xFu; }
#define XB_SPIN(cond, bar) do { unsigned _sp = 0; while (cond) { __builtin_amdgcn_s_sleep(1); \
    if ((++_sp & 255u) == 0u) { if (xb_ld(&(bar)[XB_TMO])) break; if (_sp > XB_SPIN_CAP) { atomicAdd(&(bar)[XB_TMO], 1u); break; } } } } while (0)
struct XcdBarrier { unsigned* bar; unsigned x; volatile LAS unsigned* st; };
__device__ __forceinline__ XcdBarrier xcd_barrier_post(unsigned* bar, volatile LAS unsigned* st) {
    XcdBarrier b; b.bar = bar; b.x = xb_xcc_id(); b.st = st;
    if (threadIdx.x == 0) (void)xb_add(&bar[XB_XCNT(b.x)], 1u);
    return b;
}
__device__ __forceinline__ void xcd_barrier_complete(unsigned* bar, unsigned x, unsigned& nloc, unsigned& nx) {
    const unsigned G = gridDim.x * gridDim.y * gridDim.z;
    unsigned sum, cnt, mine, sp = 0u;
    for (;;) {
        sum = 0u; cnt = 0u; mine = 0u;
#pragma unroll
        for (unsigned j = 0; j < 16; ++j) { const unsigned c = xb_ld(&bar[XB_XCNT(j)]); sum += c; cnt += (c > 0u) ? 1u : 0u; mine = (j == x) ? c : mine; }
        if (sum == G) break;
        __builtin_amdgcn_s_sleep(1);
        if ((++sp & 255u) == 0u) { if (xb_ld(&bar[XB_TMO])) break; if (sp > XB_SPIN_CAP) { atomicAdd(&bar[XB_TMO], 1u); break; } }
    }
    nloc = mine > 0u ? mine : 1u; nx = cnt > 0u ? cnt : 1u;
}
__device__ __forceinline__ void xcd_barrier(const XcdBarrier& b) {
    asm volatile("s_waitcnt vmcnt(0)" ::: "memory");
    __syncthreads();
    if (threadIdx.x == 0) {
        unsigned* bar = b.bar;
        __builtin_amdgcn_s_waitcnt(0);
        unsigned nloc = b.st[0], nx = b.st[1];
        if (nloc == 0u) { xcd_barrier_complete(bar, b.x, nloc, nx); b.st[0] = nloc; b.st[1] = nx; }
        const unsigned old = xb_add(&bar[XB_XSUB(b.x)], 1u);
        const unsigned gen = old / nloc;
        if (old + 1u == (gen + 1u) * nloc) {
            __builtin_amdgcn_fence(__ATOMIC_RELEASE, "agent");
            asm volatile("s_waitcnt vmcnt(0)" ::: "memory");
            const unsigned og = xb_add(&bar[XB_TOP], 1u);
            const unsigned tg = og / nx;
            if (og + 1u == (tg + 1u) * nx) xb_add(&bar[XB_TOPGEN], 1u);
            else XB_SPIN(xb_ld(&bar[XB_TOPGEN]) == tg, bar);
            __builtin_amdgcn_fence(__ATOMIC_ACQUIRE, "agent");
            xb_add(&bar[XB_XGEN(b.x)], 1u);
            asm volatile("s_waitcnt vmcnt(0)" ::: "memory");
        } else {
            XB_SPIN(xb_ld(&bar[XB_XGEN(b.x)]) == gen, bar);
            __builtin_amdgcn_fence(__ATOMIC_ACQUIRE, "agent");
            asm volatile("s_waitcnt vmcnt(0)" ::: "memory");
        }
    }
    __syncthreads();
}

__global__ void __launch_bounds__(256, 2) mega(Params p, int ph_lo, int ph_hi) {
  __shared__ __attribute__((aligned(16))) char smem[49152];
  __shared__ u32x4 xb_words;
  if (threadIdx.x == 0) xb_words = u32x4{0u, 0u, 0u, 0u};
  __syncthreads();
  if (ph_lo > 4096) cg::this_grid().sync();
  const XcdBarrier xb = xcd_barrier_post((unsigned*)(p.ws + OFF_BAR), (volatile LAS unsigned*)&xb_words);
  const int bid = blockIdx.x, nb = gridDim.x;
#pragma unroll
  for (int ph = 0; ph < NPH; ++ph) {
    if (ph < ph_lo || ph >= ph_hi) continue;
    if (ph > ph_lo) {
      xcd_barrier(xb);
    }
#pragma unroll
    for (int rep = 0; rep < 1 + ((DUP_MASK >> ph) & 1); ++rep)
    switch (ph) {
      case 0:
        if (nb == 512) {
          if (bid < 192) p0_mod(p, smem, bid);
          else for (int r = 0; r < 3; ++r) p0_light(p, smem, 192 + (bid - 192) + 320 * r);
          for (int it = 192 + 960 + bid; it < 3280; it += 512) p0_light(p, smem, it);
        } else {
          for (int it = bid; it < 3280; it += nb) {
            if (it < 192) p0_mod(p, smem, it);
            else p0_light(p, smem, it);
          }
        }
        break;
      case 1:
        for (int it = bid; it < 1024 + 2560; it += nb) {
          if (it < 1024) filt_item(p, smem, 1023 - it);
          else norm_item(p, it - 1024, 0);
        }
        break;
      case 2:
        if ((nb & 7) == 0) { for (int lt = bid >> 3; lt < 40 * 12; lt += nb >> 3) { int mt, nt; tile_map<12, 4>(lt, bid & 7, mt, nt); inproj0_tile(p, smem, mt, nt); } }
        else { for (int t = bid; t < 320 * 12; t += nb) inproj0_tile(p, smem, t / 12, t % 12); }
        break;
      case 3:
        for (int k = 0; bid + k * nb < 5160; ++k) {
          const int cnt = (5160 - bid + nb - 1) / nb;
          const int it = bid + ((bid >= (nb >> 1)) ? (cnt - 1 - k) : k) * nb;
          if (it < 2048) attn_na_item(p, smem, it);
          else if (it < 2560) attn_ctx_item(p, smem, it - 2048);
          else if (it < 4640) fnet_item(p, smem, it - 2560, false);
          else fnet_item(p, smem, it - 4640, true);
        }
        break;
      case 4:
        for (int it = bid; it < 10240; it += nb) xpose_item(p, smem, it, 0);
        break;
      case 5:
        if ((nb & 7) == 0) { for (int lt = bid >> 3; lt < 40 * 8; lt += nb >> 3) { int mt, nt; tile_map<8, 8>(lt, bid & 7, mt, nt); outproj_tile(p, smem, mt, nt, 0); } }
        else { for (int t = bid; t < 320 * 8; t += nb) outproj_tile(p, smem, t >> 3, t & 7, 0); }
        break;
      case 6:
        for (int it = bid; it < 2560; it += nb) norm_item(p, it, 1);
        break;
      case 7:
        if ((nb & 7) == 0) { for (int lt = bid >> 3; lt < 40 * 16; lt += nb >> 3) { int mt, nt; tile_map<16, 8>(lt, bid & 7, mt, nt); inproj1_tile(p, smem, mt, nt); } }
        else { for (int t = bid; t < 320 * 16; t += nb) inproj1_tile(p, smem, t >> 4, t & 15); }
        break;
      case 8:
        for (int it = bid; it < 2048; it += nb) {
          if (it < 1024) hyena_sample_item(p, smem, it);
          else hyena_prompt_item(p, smem, it - 1024);
        }
        break;
      case 9:
        for (int it = bid; it < 10240; it += nb) xpose_item(p, smem, it, 1);
        break;
      case 10:
        if ((nb & 7) == 0) { for (int lt = bid >> 3; lt < 40 * 8; lt += nb >> 3) { int mt, nt; tile_map<8, 8>(lt, bid & 7, mt, nt); outproj_tile(p, smem, mt, nt, 1); } }
        else { for (int t = bid; t < 320 * 8; t += nb) outproj_tile(p, smem, t >> 3, t & 7, 1); }
        break;
    }
  }
}

extern "C" void kernel_launch(void* const* d_in, const int* in_sizes, int n_in, void* d_out, int out_size, void* d_ws,
                              size_t ws_size, hipStream_t stream) {
  Params p{};
  for (int i = 0; i < 29; ++i) p.in[i] = (const float*)d_in[i];
  p.out = (float*)d_out;
  p.ws = (char*)d_ws;
  if (ws_size < WS_NEEDED) { fprintf(stderr, "workspace too small: %zu < %zu\n", ws_size, (size_t)WS_NEEDED); return; }
  static int grid_blocks = 0;
  if (!grid_blocks) {
    int dev = 0, cus = 0, per_cu = 0;
    hipGetDevice(&dev);
    hipDeviceGetAttribute(&cus, hipDeviceAttributeMultiprocessorCount, dev);
    hipOccupancyMaxActiveBlocksPerMultiprocessor(&per_cu, mega, 256, 0);
    if (per_cu > 2) per_cu = 2;
    grid_blocks = cus * per_cu;
  }
  hipMemsetAsync((char*)d_ws + OFF_BAR, 0, 16384, stream);
#if SINGLE_LAUNCH
  int lo = 0, hi = NPH;
  void* args[] = {&p, &lo, &hi};
  hipError_t e = hipLaunchCooperativeKernel((void*)mega, dim3(grid_blocks), dim3(256), args, 0, stream);
  if (e != hipSuccess) fprintf(stderr, "cooperative launch failed: %s (grid %d)\n", hipGetErrorString(e), grid_blocks);
#else
  for (int ph = 0; ph < NPH; ++ph) mega<<<grid_blocks, 256, 0, stream>>>(p, ph, ph + 1);
#endif
}
```

```cpp
#include <hip/hip_runtime.h>
#include <hip/hip_cooperative_groups.h>
#include <cstdio>
namespace cg = cooperative_groups;

#ifndef DUP_MASK
#define DUP_MASK 0
#endif
#ifndef SINGLE_LAUNCH
#define SINGLE_LAUNCH 1
#endif

#define DI __device__ __forceinline__
#define HD __device__ __forceinline__
#define SINCOSPI(x, s, c) do { *(s) = __builtin_amdgcn_sinf(0.5f * (x)); *(c) = __builtin_amdgcn_cosf(0.5f * (x)); } while (0)
#define OPAQUE(x) asm volatile("" : "+v"(x))
#ifdef DIAG_NOINLINE
#define ITEMFN __device__ __attribute__((noinline))
#else
#define ITEMFN __device__ __forceinline__
#endif

struct cpx { float x, y; };
HD cpx cmul(cpx a, cpx b) { cpx r; r.x = a.x * b.x - a.y * b.y; r.y = a.x * b.y + a.y * b.x; return r; }
HD cpx cmulc(cpx a, cpx b) { cpx r; r.x = a.x * b.x + a.y * b.y; r.y = a.y * b.x - a.x * b.y; return r; }
HD cpx cadd(cpx a, cpx b) { cpx r; r.x = a.x + b.x; r.y = a.y + b.y; return r; }
HD cpx csub(cpx a, cpx b) { cpx r; r.x = a.x - b.x; r.y = a.y - b.y; return r; }
template <bool INV> HD cpx mulmi(cpx a) { cpx r; if (!INV) { r.x = a.y; r.y = -a.x; } else { r.x = -a.y; r.y = a.x; } return r; }
template <bool INV> HD void dft4(cpx& a0, cpx& a1, cpx& a2, cpx& a3) {
  cpx s02 = cadd(a0, a2), d02 = csub(a0, a2), s13 = cadd(a1, a3), d13 = mulmi<INV>(csub(a1, a3));
  a0 = cadd(s02, s13); a2 = csub(s02, s13); a1 = cadd(d02, d13); a3 = csub(d02, d13);
}
template <bool INV> HD cpx twc(cpx a, float c, float s) {
  cpx r; if (!INV) { r.x = a.x * c + a.y * s; r.y = a.y * c - a.x * s; } else { r.x = a.x * c - a.y * s; r.y = a.y * c + a.x * s; } return r;
}
template <bool INV> HD void dft16(cpx (&v)[16]) {
#pragma unroll
  for (int b = 0; b < 4; ++b) dft4<INV>(v[b], v[4 + b], v[8 + b], v[12 + b]);
  const float C1 = 0.92387953251128674f, S1 = 0.38268343236508977f, R2 = 0.70710678118654752f;
  v[4 * 1 + 1] = twc<INV>(v[4 * 1 + 1], C1, S1);
  v[4 * 2 + 1] = twc<INV>(v[4 * 2 + 1], R2, R2);
  v[4 * 3 + 1] = twc<INV>(v[4 * 3 + 1], S1, C1);
  v[4 * 1 + 2] = twc<INV>(v[4 * 1 + 2], R2, R2);
  v[4 * 2 + 2] = mulmi<INV>(v[4 * 2 + 2]);
  v[4 * 3 + 2] = twc<INV>(v[4 * 3 + 2], -R2, R2);
  v[4 * 1 + 3] = twc<INV>(v[4 * 1 + 3], S1, C1);
  v[4 * 2 + 3] = twc<INV>(v[4 * 2 + 3], -R2, R2);
  v[4 * 3 + 3] = twc<INV>(v[4 * 3 + 3], -C1, -S1);
#pragma unroll
  for (int c = 0; c < 4; ++c) dft4<INV>(v[4 * c + 0], v[4 * c + 1], v[4 * c + 2], v[4 * c + 3]);
#pragma unroll
  for (int c = 0; c < 4; ++c)
#pragma unroll
    for (int d = c + 1; d < 4; ++d) { cpx t = v[4 * c + d]; v[4 * c + d] = v[4 * d + c]; v[4 * d + c] = t; }
}
HD int PADI(int p) { return p + (p >> 4); }
template <bool INV> HD void twiddle16(cpx (&v)[16], float c1, float s1) {
  cpx w[16];
  w[1].x = c1; w[1].y = INV ? s1 : -s1;
  w[2] = cmul(w[1], w[1]); w[3] = cmul(w[2], w[1]); w[4] = cmul(w[2], w[2]);
  w[5] = cmul(w[4], w[1]); w[6] = cmul(w[4], w[2]); w[7] = cmul(w[4], w[3]); w[8] = cmul(w[4], w[4]);
#pragma unroll
  for (int k = 9; k < 16; ++k) w[k] = cmul(w[8], w[k - 8]);
#pragma unroll
  for (int k = 1; k < 16; ++k) v[k] = cmul(v[k], w[k]);
}
template <int S, bool LOAD, bool STORE> HD void fft_fwd_pass(cpx (&v)[16], cpx* buf, int tid) {
  OPAQUE(tid);
  const int n1 = tid & (S - 1), hi = tid / S, base = hi * 16 * S + n1;
  cpx* bp = buf + PADI(base);
  constexpr int STR = S == 1 ? 1 : S + S / 16;
  if (LOAD) {
#pragma unroll
    for (int j = 0; j < 16; ++j) v[j] = bp[STR * j];
  }
  dft16<false>(v);
  if (S > 1) { int n1o = n1; OPAQUE(n1o); float s, c; SINCOSPI(2.0f * (float)n1o / (float)(16 * S), &s, &c); twiddle16<false>(v, c, s); }
  if (STORE) {
#pragma unroll
    for (int j = 0; j < 16; ++j) bp[STR * j] = v[j];
  }
}
template <int S, bool LOAD, bool STORE> HD void fft_inv_pass(cpx (&v)[16], cpx* buf, int tid) {
  OPAQUE(tid);
  const int n1 = tid & (S - 1), hi = tid / S, base = hi * 16 * S + n1;
  cpx* bp = buf + PADI(base);
  constexpr int STR = S == 1 ? 1 : S + S / 16;
  if (LOAD) {
#pragma unroll
    for (int j = 0; j < 16; ++j) v[j] = bp[STR * j];
  }
  if (S > 1) { int n1o = n1; OPAQUE(n1o); float s, c; SINCOSPI(2.0f * (float)n1o / (float)(16 * S), &s, &c); twiddle16<true>(v, c, s); }
  dft16<true>(v);
  if (STORE) {
#pragma unroll
    for (int j = 0; j < 16; ++j) bp[STR * j] = v[j];
  }
}


typedef unsigned short bfr;
using bf16x8 = __attribute__((ext_vector_type(8))) short;
using s16x4 = __attribute__((ext_vector_type(4))) short;
using f32x16 = __attribute__((ext_vector_type(16))) float;
using u32x4 = __attribute__((ext_vector_type(4))) unsigned;
using u32x2 = __attribute__((ext_vector_type(2))) unsigned;
using f32x4 = __attribute__((ext_vector_type(4))) float;
#define SB() __builtin_amdgcn_sched_barrier(0)
#define MFMA(a, b, c) __builtin_amdgcn_mfma_f32_32x32x16_bf16((a), (b), (c), 0, 0, 0)

constexpr int MT = 40960;
constexpr int MP = 8192;
constexpr int NPH = 11;

enum { I_XP = 0, I_XS, I_CK, I_CV, I_C, I_CCTX, I_NORM0G, I_MOD0W, I_MOD0B, I_IN0W, I_QNG, I_KNG, I_RELB, I_OUT0W,
       I_NORM1G, I_MOD1W, I_MOD1B, I_IN1W, I_SCW, I_SCB, I_FW1, I_FB1, I_FFR1, I_FW2, I_FB2, I_FFR2, I_FW3, I_FSKIP, I_OUT1W };

struct Params {
  const float* in[29];
  float* out;
  char* ws;
};

constexpr size_t OFF_W0T = 0;
constexpr size_t OFF_WO0T = 7340032;
constexpr size_t OFF_W1T = 9437184;
constexpr size_t OFF_WO1T = 17825792;
constexpr size_t OFF_MOD = 19922944;
constexpr size_t OFF_CKB = 20144128;
constexpr size_t OFF_CVT = 24338432;
constexpr size_t OFF_HID = 28532736;
constexpr size_t OFF_FSUM = 29646848;
constexpr size_t OFF_F256 = 29663232;
constexpr size_t OFF_F4096 = 33857536;
constexpr size_t OFF_R2 = 100966400;
constexpr size_t OFF_BIG = 184852480;
constexpr size_t OFF_R1 = OFF_BIG;
constexpr size_t OFF_AGT = OFF_BIG + 83886080;
constexpr size_t OFF_Q = OFF_BIG + 125829120;
constexpr size_t OFF_K = OFF_BIG + 167772160;
constexpr size_t OFF_VT = OFF_BIG + 209715200;
constexpr size_t OFF_BGT = OFF_BIG + 251658240;
constexpr size_t OFF_BAR = OFF_BIG + 335544320;
constexpr size_t WS_NEEDED = OFF_BAR + 16384;

constexpr size_t OUT_K = 41943040;
constexpr size_t OUT_V = 46137344;

DI int mytid() { int t = __builtin_amdgcn_workitem_id_x(); OPAQUE(t); return t; }
typedef __bf16 bf16x2_t __attribute__((ext_vector_type(2)));
DI bfr f2bf(float x) { __bf16 v = (__bf16)x; return __builtin_bit_cast(bfr, v); }
DI float bf2f(bfr b) { return __uint_as_float(((unsigned)b) << 16); }
DI unsigned pk2(float a, float b) { bf16x2_t v = {(__bf16)a, (__bf16)b}; return __builtin_bit_cast(unsigned, v); }
DI float siluf(float v) { return v * __builtin_amdgcn_rcpf(1.f + __builtin_amdgcn_exp2f(-1.4426950408889634f * v)); }
DI int crow(int i, int h) { return (i & 3) + 8 * (i >> 2) + 4 * h; }
DI int clampi(int v, int lo, int hi) { return v < lo ? lo : (v > hi ? hi : v); }

ITEMFN void p0_mod(const Params& p, char* smem, int item) {
  const int tid = mytid();
  const int layer = item / 96, nb = item % 96;
  float* sl = (float*)smem;
  float* red = sl;
  const float* c = p.in[I_C];
  const float* cc = p.in[I_CCTX];
  for (int idx = tid; idx < 9 * 1024; idx += 256) {
    int ci = idx >> 10, k = idx & 1023;
    float v = ci < 8 ? c[ci * 1024 + k] : cc[k];
    sl[idx] = v / (1.f + expf(-v));
  }
  __syncthreads();
  const float* W = (layer ? p.in[I_MOD1W] : p.in[I_MOD0W]);
  const float* B = (layer ? p.in[I_MOD1B] : p.in[I_MOD0B]);
  const int kg = tid >> 5, col = tid & 31, n = nb * 32 + col;
  float acc[9];
#pragma unroll
  for (int ci = 0; ci < 9; ++ci) acc[ci] = 0.f;
#pragma unroll 4
  for (int k = kg * 128; k < kg * 128 + 128; ++k) {
    float w = W[(size_t)k * 3072 + n];
#pragma unroll
    for (int ci = 0; ci < 9; ++ci) acc[ci] += sl[ci * 1024 + k] * w;
  }
  __syncthreads();
#pragma unroll
  for (int ci = 0; ci < 9; ++ci) red[(kg * 9 + ci) * 32 + col] = acc[ci];
  __syncthreads();
  float* mod = (float*)(p.ws + OFF_MOD) + layer * 9 * 3072;
  for (int idx = tid; idx < 288; idx += 256) {
    int ci = idx >> 5, cl = idx & 31;
    float s = 0.f;
    for (int k2 = 0; k2 < 8; ++k2) s += red[(k2 * 9 + ci) * 32 + cl];
    mod[ci * 3072 + nb * 32 + cl] = s + B[nb * 32 + cl];
  }
  __syncthreads();
}

ITEMFN void p0_fold(const Params& p, char* smem, int item) {
  const int tid = mytid();
  const int g = item >> 5, k0 = (item & 31) * 32;
  float* a = (float*)smem;
  float* ct = a + 32 * 128;
  float* st = ct + 128;
  const float* W = p.in[I_IN0W];
  for (int idx = tid; idx < 32 * 128; idx += 256) {
    int kk = idx >> 7, cc = idx & 127;
    a[idx] = W[(size_t)(k0 + kk) * 3072 + g * 128 + cc];
  }
  if (tid < 128) { float s, c; sincospif(2.f * (float)tid / 128.f, &s, &c); ct[tid] = c; st[tid] = s; }
  __syncthreads();
  const int q = tid & 127, kh = tid >> 7;
  const int k2 = q <= 64 ? q : q - 64;
  float acc[16];
#pragma unroll
  for (int kk = 0; kk < 16; ++kk) acc[kk] = 0.f;
#pragma unroll 1
  for (int cc = 0; cc < 128; ++cc) {
    int idx = (k2 * cc) & 127;
    float t = q <= 64 ? ct[idx] : -st[idx];
#pragma unroll
    for (int kk = 0; kk < 16; ++kk) acc[kk] += a[(kh * 16 + kk) * 128 + cc] * t;
  }
  bfr* dst = (bfr*)(p.ws + OFF_W0T) + (size_t)(g * 128 + q) * 1024 + k0 + kh * 16;
#pragma unroll
  for (int qq = 0; qq < 2; ++qq) {
    u32x4 v;
    v.x = pk2(acc[8 * qq + 0], acc[8 * qq + 1]); v.y = pk2(acc[8 * qq + 2], acc[8 * qq + 3]);
    v.z = pk2(acc[8 * qq + 4], acc[8 * qq + 5]); v.w = pk2(acc[8 * qq + 6], acc[8 * qq + 7]);
    *(u32x4*)(dst + 8 * qq) = v;
  }
  __syncthreads();
}

ITEMFN void p0_transpose(const Params& p, char* smem, int item) {
  const int tid = mytid();
  int nt = item >> 4;
  const int k0 = (item & 15) * 64;
  const float* src; int ld, coloff; bfr* dst;
  if (nt < 40) { src = p.in[I_IN0W]; ld = 3072; coloff = 512 + nt * 64; dst = (bfr*)(p.ws + OFF_W0T) + (size_t)(512 + nt * 64) * 1024; }
  else if (nt < 56) { nt -= 40; src = p.in[I_OUT0W]; ld = 1024; coloff = nt * 64; dst = (bfr*)(p.ws + OFF_WO0T) + (size_t)(nt * 64) * 1024; }
  else if (nt < 120) { nt -= 56; src = p.in[I_IN1W]; ld = 4096; coloff = nt * 64; dst = (bfr*)(p.ws + OFF_W1T) + (size_t)(nt * 64) * 1024; }
  else { nt -= 120; src = p.in[I_OUT1W]; ld = 1024; coloff = nt * 64; dst = (bfr*)(p.ws + OFF_WO1T) + (size_t)(nt * 64) * 1024; }
  float* t = (float*)smem;
#pragma unroll
  for (int i = 0; i < 4; ++i) {
    int idx = tid + 256 * i, kk = idx >> 4, c4 = idx & 15;
    f32x4 v = *(const f32x4*)(src + (size_t)(k0 + kk) * ld + coloff + 4 * c4);
    t[kk * 65 + 4 * c4 + 0] = v.x; t[kk * 65 + 4 * c4 + 1] = v.y; t[kk * 65 + 4 * c4 + 2] = v.z; t[kk * 65 + 4 * c4 + 3] = v.w;
  }
  __syncthreads();
#pragma unroll
  for (int i = 0; i < 2; ++i) {
    int idx = tid + 256 * i, nn = idx >> 3, kc = idx & 7;
    float f[8];
#pragma unroll
    for (int e = 0; e < 8; ++e) f[e] = t[(8 * kc + e) * 65 + nn];
    u32x4 v; v.x = pk2(f[0], f[1]); v.y = pk2(f[2], f[3]); v.z = pk2(f[4], f[5]); v.w = pk2(f[6], f[7]);
    *(u32x4*)(dst + (size_t)nn * 1024 + k0 + 8 * kc) = v;
  }
  __syncthreads();
}

ITEMFN void p0_cache(const Params& p, char* smem, int item) {
  const int tid = mytid();
  const int b = item >> 6, hd = (item >> 3) & 7, p0 = (item & 7) * 64;
  const float* ck = p.in[I_CK];
  const float* cv = p.in[I_CV];
  bfr* dk = (bfr*)(p.ws + OFF_CKB);
  bfr* dv = (bfr*)(p.ws + OFF_CVT);
  float* t = (float*)smem;
#pragma unroll
  for (int i = 0; i < 4; ++i) {
    int idx = tid + 256 * i, pp = idx >> 4, c4 = idx & 15;
    size_t so = ((size_t)(b * 512 + p0 + pp) * 8 + hd) * 64 + 4 * c4;
    f32x4 kv = *(const f32x4*)(ck + so);
    u32x2 o; o.x = pk2(kv.x, kv.y); o.y = pk2(kv.z, kv.w);
    *(u32x2*)(dk + ((size_t)(b * 8 + hd) * 512 + p0 + pp) * 64 + 4 * c4) = o;
    f32x4 v = *(const f32x4*)(cv + so);
    t[pp * 65 + 4 * c4 + 0] = v.x; t[pp * 65 + 4 * c4 + 1] = v.y; t[pp * 65 + 4 * c4 + 2] = v.z; t[pp * 65 + 4 * c4 + 3] = v.w;
  }
  __syncthreads();
#pragma unroll
  for (int i = 0; i < 2; ++i) {
    int idx = tid + 256 * i, dd = idx >> 3, pc = idx & 7;
    float f[8];
#pragma unroll
    for (int e = 0; e < 8; ++e) f[e] = t[(8 * pc + e) * 65 + dd];
    u32x4 v; v.x = pk2(f[0], f[1]); v.y = pk2(f[2], f[3]); v.z = pk2(f[4], f[5]); v.w = pk2(f[6], f[7]);
    *(u32x4*)(dv + ((size_t)(b * 8 + hd) * 64 + dd) * 512 + p0 + 8 * pc) = v;
  }
  __syncthreads();
}

ITEMFN void p0_hid(const Params& p, char* smem, int item) {
  const int tid = mytid();
  const int variant = item >= 16 ? 1 : 0;
  const int tb = variant ? item - 16 : item;
  const int L = variant ? 4096 : 256;
  float* w1s = (float*)smem;
  float* w2s = w1s + 2112;
  float* z = w2s + 4096;
  float* h1 = z + 144;
  for (int idx = tid; idx < 2112; idx += 256) w1s[idx] = p.in[I_FW1][idx];
  for (int idx = tid; idx < 4096; idx += 256) w2s[idx] = p.in[I_FW2][idx];
  const int tt = tid >> 6, j = tid & 63;
  const float b1 = p.in[I_FB1][j], f1 = p.in[I_FFR1][j], b2 = p.in[I_FB2][j], f2 = p.in[I_FFR2][j];
  float* hid = (float*)(p.ws + OFF_HID) + (variant ? 256 * 64 : 0);
  __syncthreads();
#pragma unroll 1
  for (int rd = 0; rd < 4; ++rd) {
    const int t = tb * 16 + rd * 4 + tt;
    if (j < 33) {
      float val;
      if (j == 0) val = (float)t / (float)(L - 1);
      else {
        int b = (j - 1) & 15;
        float f = 1e-4f + (float)b * ((15.0f - 1e-4f) / 15.0f);
        float w = (6.283185307179586f * (float)t) / (float)L;
        float a = f * w;
        val = j <= 16 ? cosf(a) : -sinf(a);
      }
      z[tt * 36 + j] = val;
    }
    __syncthreads();
    float pre = b1;
#pragma unroll
    for (int i = 0; i < 33; ++i) pre += z[tt * 36 + i] * w1s[i * 64 + j];
    h1[tt * 64 + j] = sinf(f1 * pre);
    __syncthreads();
    float pre2 = b2;
#pragma unroll 16
    for (int i = 0; i < 64; ++i) pre2 += h1[tt * 64 + i] * w2s[i * 64 + j];
    hid[(size_t)j * L + t] = sinf(f2 * pre2);
    __syncthreads();
  }
}

ITEMFN void norm_item(const Params& p, int item, int layer) {
  const int tid = mytid(), lane = tid & 63, wave = tid >> 6;
  const float* g = (layer ? p.in[I_NORM1G] : p.in[I_NORM0G]);
  const float* mod = (const float*)(p.ws + OFF_MOD) + layer * 9 * 3072;
  bfr* dst = (bfr*)(p.ws + (layer ? OFF_R2 : OFF_R1));
  for (int rr = 0; rr < 4; ++rr) {
    const int m = item * 16 + wave * 4 + rr;
    const float* xr = layer ? (const float*)p.out + (size_t)m * 1024
                            : (m < MP ? p.in[I_XP] + (size_t)m * 1024 : p.in[I_XS] + (size_t)(m - MP) * 1024);
    const int ci = m < MP ? 8 : (m - MP) >> 12;
    f32x4 v[4];
    float ss = 0.f;
#pragma unroll
    for (int i = 0; i < 4; ++i) {
      v[i] = *(const f32x4*)(xr + lane * 4 + 256 * i);
      ss += v[i].x * v[i].x + v[i].y * v[i].y + v[i].z * v[i].z + v[i].w * v[i].w;
    }
#pragma unroll
    for (int o = 32; o >= 1; o >>= 1) ss += __shfl_xor(ss, o);
    const float rs = rsqrtf(ss * (1.f / 1024.f) + 1e-6f);
#pragma unroll
    for (int i = 0; i < 4; ++i) {
      const int col = lane * 4 + 256 * i;
      f32x4 g4 = *(const f32x4*)(g + col);
      f32x4 sh = *(const f32x4*)(mod + ci * 3072 + col);
      f32x4 sc = *(const f32x4*)(mod + ci * 3072 + 1024 + col);
      float a = v[i].x * rs * g4.x * (1.f + sc.x) + sh.x;
      float b = v[i].y * rs * g4.y * (1.f + sc.y) + sh.y;
      float c = v[i].z * rs * g4.z * (1.f + sc.z) + sh.z;
      float d = v[i].w * rs * g4.w * (1.f + sc.w) + sh.w;
      u32x2 o; o.x = pk2(a, b); o.y = pk2(c, d);
      *(u32x2*)(dst + (size_t)m * 1024 + col) = o;
    }
  }
}

template <int NT>
DI void filt_body(const Params& p, float* wl, float* red, int tid, int variant, int order, int w0) {
  constexpr int L = NT * 256;
  const float* hid = (const float*)(p.ws + OFF_HID) + (variant ? 256 * 64 : 0);
  float* F = (float*)(p.ws + (variant ? OFF_F4096 : OFF_F256));
  float acc[NT][8];
#pragma unroll
  for (int i = 0; i < NT; ++i)
#pragma unroll
    for (int c8 = 0; c8 < 8; ++c8) acc[i][c8] = 0.f;
#pragma unroll 4
  for (int k = 0; k < 64; ++k) {
    float hv[NT];
#pragma unroll
    for (int i = 0; i < NT; ++i) hv[i] = hid[(size_t)k * L + tid + 256 * i];
    const f32x4 wa = *(const f32x4*)(wl + k * 8);
    const f32x4 wb = *(const f32x4*)(wl + k * 8 + 4);
#pragma unroll
    for (int i = 0; i < NT; ++i) {
      acc[i][0] += hv[i] * wa.x; acc[i][1] += hv[i] * wa.y; acc[i][2] += hv[i] * wa.z; acc[i][3] += hv[i] * wa.w;
      acc[i][4] += hv[i] * wb.x; acc[i][5] += hv[i] * wb.y; acc[i][6] += hv[i] * wb.z; acc[i][7] += hv[i] * wb.w;
    }
  }
  const float MIND = -3.0701134573253947f, MAXD = -15.350567286626973f;
  float asum[4] = {0.f, 0.f, 0.f, 0.f};
#pragma unroll
  for (int i = 0; i < NT; ++i) {
    const int t = tid + 256 * i;
    const float tn = (float)t / (float)(L - 1);
#pragma unroll
    for (int wi = 0; wi < 4; ++wi) {
      const float delta = fabsf(MIND + (float)(w0 + wi) * ((MAXD - MIND) / 1023.f));
      const float dec = expf(-tn * delta);
#pragma unroll
      for (int dir = 0; dir < 2; ++dir) {
        const float val = acc[i][dir * 4 + wi] * dec;
        asum[wi] += fabsf(val);
        F[((size_t)(dir * 2 + order) * 1024 + w0 + wi) * L + t] = val;
      }
    }
  }
#pragma unroll
  for (int wi = 0; wi < 4; ++wi) {
#pragma unroll
    for (int o = 32; o >= 1; o >>= 1) asum[wi] += __shfl_xor(asum[wi], o);
  }
  if ((tid & 63) == 0) {
#pragma unroll
    for (int wi = 0; wi < 4; ++wi) red[(tid >> 6) * 4 + wi] = asum[wi];
  }
}

ITEMFN void filt_item(const Params& p, char* smem, int item) {
  const int tid = mytid();
  const int variant = item >> 9, order = (item >> 8) & 1, w0 = (item & 255) * 4;
  float* wl = (float*)smem;
  float* red = wl + 512;
  const float* w3 = p.in[I_FW3];
  for (int idx = tid; idx < 512; idx += 256) {
    int k = idx >> 3, c8 = idx & 7, dir = c8 >> 2, wi = c8 & 3;
    wl[idx] = w3[(size_t)k * 4096 + dir * 2048 + order * 1024 + w0 + wi];
  }
  __syncthreads();
  if (variant) filt_body<16>(p, wl, red, tid, variant, order, w0);
  else filt_body<1>(p, wl, red, tid, variant, order, w0);
  __syncthreads();
  if (tid < 4) {
    float* fsum = (float*)(p.ws + OFF_FSUM);
    fsum[(variant * 2 + order) * 1024 + w0 + tid] = red[tid] + red[4 + tid] + red[8 + tid] + red[12 + tid];
  }
  __syncthreads();
}

DI int swz(int row, int chunk) { return row * 128 + (((chunk ^ (row >> 1) ^ (row >> 4)) & 7) << 4); }

template <bool AT>
DI void g_load(u32x4 (&rx)[4], u32x4 (&rw)[4], const bfr* __restrict__ X, const bfr* __restrict__ W, int m0, int n0, int k0) {
  const int tid = mytid();
#pragma unroll
  for (int i = 0; i < 4; ++i) {
    const int row = (tid >> 3) + 32 * i, c = tid & 7;
    rw[i] = *(const u32x4*)(W + (size_t)(n0 + row) * 1024 + k0 + 8 * c);
    if (!AT) rx[i] = *(const u32x4*)(X + (size_t)(m0 + row) * 1024 + k0 + 8 * c);
  }
  if (AT) {
#pragma unroll
    for (int i = 0; i < 2; ++i) {
      const int idx = tid + 256 * i, mc = idx & 15, kp = idx >> 4;
      rx[2 * i] = *(const u32x4*)(X + (size_t)(k0 + 2 * kp) * MT + m0 + 8 * mc);
      rx[2 * i + 1] = *(const u32x4*)(X + (size_t)(k0 + 2 * kp + 1) * MT + m0 + 8 * mc);
    }
  }
}
template <bool AT>
DI void g_store(const u32x4 (&rx)[4], const u32x4 (&rw)[4], char* Xs, char* Ws) {
  const int tid = mytid();
#pragma unroll
  for (int i = 0; i < 4; ++i) {
    const int row = (tid >> 3) + 32 * i, c = tid & 7;
    *(u32x4*)(Ws + swz(row, c)) = rw[i];
    if (!AT) *(u32x4*)(Xs + swz(row, c)) = rx[i];
  }
  if (AT) {
#pragma unroll
    for (int i = 0; i < 2; ++i) {
      const int idx = tid + 256 * i, mc = idx & 15, kp = idx >> 4;
      const unsigned lo[4] = {rx[2 * i].x, rx[2 * i].y, rx[2 * i].z, rx[2 * i].w};
      const unsigned hi[4] = {rx[2 * i + 1].x, rx[2 * i + 1].y, rx[2 * i + 1].z, rx[2 * i + 1].w};
#pragma unroll
      for (int e = 0; e < 8; ++e) {
        const unsigned a = lo[e >> 1], b = hi[e >> 1];
        const unsigned val = (e & 1) ? ((a >> 16) | (b & 0xffff0000u)) : ((a & 0xffffu) | (b << 16));
        const int row = 8 * mc + e;
        *(unsigned*)(Xs + swz(row, kp >> 2) + (kp & 3) * 4) = val;
      }
    }
  }
}

template <bool AT, bool SWAP>
DI void gemm_main(f32x16 (&acc)[2][2], const bfr* __restrict__ X, const bfr* __restrict__ W, int m0, int n0, char* smem) {
  char* Xs = smem;
  char* Ws = smem + 16384;
  const int tid = mytid(), lane = tid & 63, wave = tid >> 6, r = lane & 31, h = lane >> 5;
  const int wm = wave >> 1, wn = wave & 1;
#pragma unroll
  for (int a = 0; a < 2; ++a)
#pragma unroll
    for (int b = 0; b < 2; ++b)
#pragma unroll
      for (int i = 0; i < 16; ++i) acc[a][b][i] = 0.f;
  u32x4 rx[4], rw[4];
  g_load<AT>(rx, rw, X, W, m0, n0, 0);
  for (int kt = 0; kt < 16; ++kt) {
    __syncthreads();
    g_store<AT>(rx, rw, Xs, Ws);
    __syncthreads();
    if (kt < 15) g_load<AT>(rx, rw, X, W, m0, n0, (kt + 1) * 64);
#pragma unroll
    for (int s = 0; s < 4; ++s) {
      bf16x8 xf[2], wf[2];
#pragma unroll
      for (int t = 0; t < 2; ++t) {
        xf[t] = *(const bf16x8*)(Xs + swz(64 * wm + 32 * t + r, 2 * s + h));
        wf[t] = *(const bf16x8*)(Ws + swz(64 * wn + 32 * t + r, 2 * s + h));
      }
#pragma unroll
      for (int a = 0; a < 2; ++a)
#pragma unroll
        for (int b = 0; b < 2; ++b) {
          if (SWAP) acc[a][b] = MFMA(wf[a], xf[b], acc[a][b]);
          else acc[a][b] = MFMA(xf[a], wf[b], acc[a][b]);
        }
    }
  }
}

DI void gemm_main_big(f32x16 (&acc)[4][2], const bfr* __restrict__ X, const bfr* __restrict__ W, int m0, int n0, char* smem) {
  char* Xs = smem;
  char* Ws = smem + 16384;
  const int tid = mytid(), lane = tid & 63, wave = tid >> 6, r = lane & 31, h = lane >> 5;
  const int wm = wave >> 1, wn = wave & 1;
#pragma unroll
  for (int a = 0; a < 4; ++a)
#pragma unroll
    for (int b = 0; b < 2; ++b)
#pragma unroll
      for (int i = 0; i < 16; ++i) acc[a][b][i] = 0.f;
  u32x4 rx[4], rw[8];
  const int lrow = tid >> 3, lc = tid & 7;
  const bfr* xp = X + (size_t)(m0 + lrow) * 1024 + 8 * lc;
  const bfr* wp = W + (size_t)(n0 + lrow) * 1024 + 8 * lc;
#pragma unroll
  for (int i = 0; i < 4; ++i) rx[i] = *(const u32x4*)(xp + (size_t)(32 * i) * 1024);
#pragma unroll
  for (int i = 0; i < 8; ++i) rw[i] = *(const u32x4*)(wp + (size_t)(32 * i) * 1024);
  for (int kt = 0; kt < 16; ++kt) {
    __syncthreads();
#pragma unroll
    for (int i = 0; i < 4; ++i) *(u32x4*)(Xs + swz(lrow + 32 * i, lc)) = rx[i];
#pragma unroll
    for (int i = 0; i < 8; ++i) *(u32x4*)(Ws + swz(lrow + 32 * i, lc)) = rw[i];
    __syncthreads();
    if (kt < 15) {
#pragma unroll
      for (int i = 0; i < 4; ++i) rx[i] = *(const u32x4*)(xp + (size_t)(32 * i) * 1024 + (kt + 1) * 64);
#pragma unroll
      for (int i = 0; i < 8; ++i) rw[i] = *(const u32x4*)(wp + (size_t)(32 * i) * 1024 + (kt + 1) * 64);
    }
#pragma unroll
    for (int s = 0; s < 4; ++s) {
      bf16x8 xf[2], wf[4];
#pragma unroll
      for (int t = 0; t < 2; ++t) xf[t] = *(const bf16x8*)(Xs + swz(64 * wm + 32 * t + r, 2 * s + h));
#pragma unroll
      for (int t = 0; t < 4; ++t) wf[t] = *(const bf16x8*)(Ws + swz(128 * wn + 32 * t + r, 2 * s + h));
#pragma unroll
      for (int a = 0; a < 4; ++a)
#pragma unroll
        for (int b = 0; b < 2; ++b) acc[a][b] = MFMA(wf[a], xf[b], acc[a][b]);
    }
  }
}

template <bool SILU>
DI void store_T4(const f32x16 (&acc)[4][2], bfr* dst, int nrow0, int mcol0, int r, int h) {
#pragma unroll
  for (int tn = 0; tn < 4; ++tn)
#pragma unroll
    for (int tm = 0; tm < 2; ++tm)
#pragma unroll
      for (int i = 0; i < 16; ++i) {
        float v = acc[tn][tm][i];
        if (SILU) v = siluf(v);
        dst[(size_t)(nrow0 + 32 * tn + crow(i, h)) * MT + mcol0 + 32 * tm + r] = f2bf(v);
      }
}

template <bool SILU>
DI void store_T4_lds(const f32x16 (&acc)[4][2], bfr* dst, int nrow0, int mcol0, char* smem, int wave, int lane) {
  const int r = lane & 31, h = lane >> 5;
  char* reg = smem + wave * 9216;
  __syncthreads();
#pragma unroll
  for (int half = 0; half < 2; ++half) {
#pragma unroll
    for (int t2 = 0; t2 < 2; ++t2)
#pragma unroll
      for (int tm = 0; tm < 2; ++tm)
#pragma unroll
        for (int i = 0; i < 16; ++i) {
          float v = acc[2 * half + t2][tm][i];
          if (SILU) v = siluf(v);
          *(bfr*)(reg + (32 * t2 + crow(i, h)) * 144 + (32 * tm + r) * 2) = f2bf(v);
        }
    __syncthreads();
#pragma unroll
    for (int q = 0; q < 8; ++q) {
      const int idx = lane + 64 * q, row = idx >> 3, ch = idx & 7;
      const u32x4 v = *(const u32x4*)(reg + row * 144 + ch * 16);
      __builtin_nontemporal_store(v, (u32x4*)(dst + (size_t)(nrow0 + 64 * half + row) * MT + mcol0 + 8 * ch));
    }
    __syncthreads();
  }
}

template <bool SILU>
DI void store_T(const f32x16 (&acc)[2][2], bfr* dst, int nrow0, int mcol0, int r, int h) {
#pragma unroll
  for (int tn = 0; tn < 2; ++tn)
#pragma unroll
    for (int tm = 0; tm < 2; ++tm)
#pragma unroll
      for (int i = 0; i < 16; ++i) {
        float v = acc[tn][tm][i];
        if (SILU) v = siluf(v);
        dst[(size_t)(nrow0 + 32 * tn + crow(i, h)) * MT + mcol0 + 32 * tm + r] = f2bf(v);
      }
}

template <int NT, int GN>
DI void tile_map(int lt, int x, int& mt, int& nt) {
  const int grp = lt / (8 * GN), in = lt % (8 * GN);
  const int lmh = grp / (NT / GN), nth = grp % (NT / GN);
  mt = (lmh * 8 + in / GN) * 8 + x;
  nt = nth * GN + in % GN;
}

ITEMFN void inproj0_tile(const Params& p, char* smem, int mt, int nt) {
  const int m0 = mt * 128, n0 = nt * 256;
  f32x16 acc[4][2];
  gemm_main_big(acc, (const bfr*)(p.ws + OFF_R1), (const bfr*)(p.ws + OFF_W0T), m0, n0, smem);
  const int tid = mytid(), lane = tid & 63, wave = tid >> 6, r = lane & 31, h = lane >> 5;
  const int mb = m0 + 64 * (wave >> 1), nb = n0 + 128 * (wave & 1);
  if (n0 < 512) { store_T4_lds<false>(acc, (bfr*)(p.ws + OFF_R2), nb, mb, smem, wave, lane); return; }
  const int region = (n0 - 512) >> 9;
  const int nl = nb - 512 - region * 512;
  if (region == 0) { store_T4_lds<true>(acc, (bfr*)(p.ws + OFF_AGT), nl, mb, smem, wave, lane); return; }
  if (region == 4) { store_T4_lds<true>(acc, (bfr*)(p.ws + OFF_BGT), nl, mb, smem, wave, lane); return; }
  if (region == 3) {
    store_T4_lds<false>(acc, (bfr*)(p.ws + OFF_VT), nl, mb, smem, wave, lane);
    if (m0 < MP) {
      float* ov = p.out + OUT_V;
#pragma unroll
      for (int tn = 0; tn < 4; ++tn)
#pragma unroll
        for (int tm = 0; tm < 2; ++tm)
#pragma unroll
          for (int g4 = 0; g4 < 4; ++g4) {
            f32x4 o; o.x = acc[tn][tm][4 * g4]; o.y = acc[tn][tm][4 * g4 + 1]; o.z = acc[tn][tm][4 * g4 + 2]; o.w = acc[tn][tm][4 * g4 + 3];
            *(f32x4*)(ov + (size_t)(mb + 32 * tm + r) * 512 + nl + 32 * tn + 8 * g4 + 4 * h) = o;
          }
    }
    return;
  }
  const float* gg = (region == 1 ? p.in[I_QNG] : p.in[I_KNG]);
  const float qs = region == 1 ? 0.125f * 1.4426950408889634f : 1.f;
  bfr* dst = (bfr*)(p.ws + (region == 1 ? OFF_Q : OFF_K));
#pragma unroll
  for (int tm = 0; tm < 2; ++tm) {
    const int m = mb + 32 * tm + r;
#pragma unroll
    for (int hh = 0; hh < 2; ++hh) {
      float ss = 0.f;
#pragma unroll
      for (int t2 = 0; t2 < 2; ++t2)
#pragma unroll
        for (int i = 0; i < 16; ++i) ss += acc[2 * hh + t2][tm][i] * acc[2 * hh + t2][tm][i];
      ss += __shfl_xor(ss, 32);
      const float rs = rsqrtf(ss * (1.f / 64.f) + 1e-6f);
#pragma unroll
      for (int t2 = 0; t2 < 2; ++t2)
#pragma unroll
        for (int g4 = 0; g4 < 4; ++g4) {
          const int d0 = 32 * t2 + 8 * g4 + 4 * h;
          f32x4 gv = *(const f32x4*)(gg + d0);
          f32x4 o;
          o.x = acc[2 * hh + t2][tm][4 * g4] * rs * gv.x; o.y = acc[2 * hh + t2][tm][4 * g4 + 1] * rs * gv.y;
          o.z = acc[2 * hh + t2][tm][4 * g4 + 2] * rs * gv.z; o.w = acc[2 * hh + t2][tm][4 * g4 + 3] * rs * gv.w;
          const int col = nl + 64 * hh + d0;
          if (region == 2 && m0 < MP) *(f32x4*)(p.out + OUT_K + (size_t)m * 512 + col) = o;
          u32x2 ob; ob.x = pk2(o.x * qs, o.y * qs); ob.y = pk2(o.z * qs, o.w * qs);
          *(u32x2*)(dst + (size_t)m * 512 + col) = ob;
        }
    }
  }
}

ITEMFN void inproj1_tile(const Params& p, char* smem, int mt, int nt) {
  const int m0 = mt * 128, n0 = nt * 256;
  f32x16 acc[4][2];
  gemm_main_big(acc, (const bfr*)(p.ws + OFF_R2), (const bfr*)(p.ws + OFF_W1T), m0, n0, smem);
  const int tid = mytid(), lane = tid & 63, wave = tid >> 6, r = lane & 31, h = lane >> 5;
  store_T4_lds<false>(acc, (bfr*)(p.ws + OFF_BIG), n0 + 128 * (wave & 1), m0 + 64 * (wave >> 1), smem, wave, lane);
}

ITEMFN void outproj_tile(const Params& p, char* smem, int mt, int nt, int layer) {
  const int m0 = mt * 128, n0 = nt * 128;
  f32x16 acc[2][2];
  gemm_main<false, false>(acc, (const bfr*)(p.ws + (layer ? OFF_BIG : OFF_R2)), (const bfr*)(p.ws + (layer ? OFF_WO1T : OFF_WO0T)), m0, n0, smem);
  const int tid = mytid(), lane = tid & 63, wave = tid >> 6, r = lane & 31, h = lane >> 5;
  const int mb = m0 + 64 * (wave >> 1), nb = n0 + 64 * (wave & 1);
  const float* mod = (const float*)(p.ws + OFF_MOD) + layer * 9 * 3072;
  const int ci = m0 < MP ? 8 : (m0 - MP) >> 12;
#pragma unroll
  for (int tm = 0; tm < 2; ++tm)
#pragma unroll
    for (int tn = 0; tn < 2; ++tn) {
      const int n = nb + 32 * tn + r;
      const float gate = mod[ci * 3072 + 2048 + n];
#pragma unroll
      for (int i = 0; i < 16; ++i) {
        const int m = mb + 32 * tm + crow(i, h);
        float xin;
        if (layer) xin = __builtin_nontemporal_load(p.out + (size_t)m * 1024 + n);
        else xin = m < MP ? __builtin_nontemporal_load(p.in[I_XP] + (size_t)m * 1024 + n) : __builtin_nontemporal_load(p.in[I_XS] + (size_t)(m - MP) * 1024 + n);
        const float res = xin + gate * acc[tm][tn][i];
        if (layer) __builtin_nontemporal_store(res, p.out + (size_t)m * 1024 + n);
        else p.out[(size_t)m * 1024 + n] = res;
      }
    }
}

ITEMFN void xpose_item(const Params& p, char* smem, int item, int layer) {
  const int tid = mytid();
  const bfr* src = (const bfr*)(p.ws + (layer ? OFF_R2 : OFF_R1));
  bfr* dst = (bfr*)(p.ws + (layer ? OFF_BIG : OFF_R2));
  const int k0 = (item & 15) * 64, m0 = (item >> 4) * 64;
  unsigned* t = (unsigned*)smem;
  {
    const int mc = tid & 7, kp = tid >> 3;
    const u32x4 a = *(const u32x4*)(src + (size_t)(k0 + 2 * kp) * MT + m0 + 8 * mc);
    const u32x4 b = *(const u32x4*)(src + (size_t)(k0 + 2 * kp + 1) * MT + m0 + 8 * mc);
    const unsigned lo[4] = {a.x, a.y, a.z, a.w};
    const unsigned hi[4] = {b.x, b.y, b.z, b.w};
#pragma unroll
    for (int e = 0; e < 8; ++e) {
      const unsigned x = lo[e >> 1], y = hi[e >> 1];
      const unsigned val = (e & 1) ? ((x >> 16) | (y & 0xffff0000u)) : ((x & 0xffffu) | (y << 16));
      t[(8 * mc + e) * 33 + kp] = val;
    }
  }
  __syncthreads();
#pragma unroll
  for (int i = 0; i < 2; ++i) {
    const int idx = tid + 256 * i, c = idx & 7, m = idx >> 3;
    u32x4 v;
    v.x = t[m * 33 + 4 * c + 0]; v.y = t[m * 33 + 4 * c + 1]; v.z = t[m * 33 + 4 * c + 2]; v.w = t[m * 33 + 4 * c + 3];
    *(u32x4*)(dst + (size_t)(m0 + m) * 1024 + k0 + 8 * c) = v;
  }
  __syncthreads();
}

struct AttnState { f32x16 o[2]; float mrun, lrun; };

DI void kv_gload(u32x4 (&kr)[2], u32x4 (&vr)[2], const bfr* kptr, size_t kstride, const bfr* vptr, size_t vstride, int tid) {
#pragma unroll
  for (int i = 0; i < 2; ++i) {
    const int idx = tid + 256 * i, row = idx >> 3, c = idx & 7;
    kr[i] = *(const u32x4*)(kptr + (size_t)row * kstride + 8 * c);
    vr[i] = *(const u32x4*)(vptr + (size_t)row * vstride + 8 * c);
  }
}
DI void kv_lstore(const u32x4 (&kr)[2], const u32x4 (&vr)[2], char* Ks, char* Vs, int tid) {
#pragma unroll
  for (int i = 0; i < 2; ++i) {
    const int idx = tid + 256 * i, row = idx >> 3, c = idx & 7;
    *(u32x4*)(Ks + row * 144 + c * 16) = kr[i];
    *(u32x4*)(Vs + row * 144 + c * 16) = vr[i];
  }
}

template <bool LOCAL>
DI void attn_chunk(AttnState& st, const bf16x8 (&qf)[4], const char* Ks, const char* Vs, int r, int h,
                   const float* brow, int qc, int cs) {
#pragma unroll
  for (int kt = 0; kt < 2; ++kt) {
    f32x16 s;
#pragma unroll
    for (int i = 0; i < 16; ++i) s[i] = 0.f;
#pragma unroll
    for (int sd = 0; sd < 4; ++sd) {
      bf16x8 kf = *(const bf16x8*)(Ks + (kt * 32 + r) * 144 + (16 * sd + 8 * h) * 2);
      s = MFMA(kf, qf[sd], s);
    }
    if (LOCAL) {
#pragma unroll
      for (int i = 0; i < 16; ++i) {
        const int kc = kt * 32 + crow(i, h);
        const bool valid = (kc >= cs) && (kc < cs + 16);
        const int bi = clampi(kc - qc + 15, 0, 30);
        s[i] = valid ? s[i] + brow[bi] : -INFINITY;
      }
    }
    float mx = s[0];
#pragma unroll
    for (int i = 1; i < 16; ++i) mx = fmaxf(mx, s[i]);
    mx = fmaxf(mx, __shfl_xor(mx, 32));
    if (__builtin_amdgcn_ballot_w64(mx - st.mrun > 8.0f) != 0ull) {
      const float mnew = fmaxf(st.mrun, mx);
      const float alpha = __builtin_amdgcn_exp2f(st.mrun - mnew);
      st.lrun *= alpha;
#pragma unroll
      for (int td = 0; td < 2; ++td)
#pragma unroll
        for (int i = 0; i < 16; ++i) st.o[td][i] *= alpha;
      st.mrun = mnew;
    }
    float ps = 0.f;
#pragma unroll
    for (int i = 0; i < 16; ++i) { s[i] = __builtin_amdgcn_exp2f(s[i] - st.mrun); ps += s[i]; }
    st.lrun += ps;
#pragma unroll
    for (int sp = 0; sp < 2; ++sp) {
      bf16x8 pf;
#pragma unroll
      for (int j = 0; j < 8; ++j) pf[j] = (short)f2bf(s[8 * sp + j]);
#pragma unroll
      for (int td = 0; td < 2; ++td) {
        const char* vp = Vs + (32 * td + r) * 144 + (kt * 32 + 16 * sp + 4 * h) * 2;
        s16x4 lo = *(const s16x4*)vp;
        s16x4 hi = *(const s16x4*)(vp + 16);
        bf16x8 vf;
        vf[0] = lo[0]; vf[1] = lo[1]; vf[2] = lo[2]; vf[3] = lo[3];
        vf[4] = hi[0]; vf[5] = hi[1]; vf[6] = hi[2]; vf[7] = hi[3];
        st.o[td] = MFMA(vf, pf, st.o[td]);
      }
    }
  }
}

DI void attn_finish(const Params& p, AttnState& st, int hd, size_t m, int h) {
  const float l = st.lrun + __shfl_xor(st.lrun, 32);
  const float inv = 1.f / l;
  const bfr* bg = (const bfr*)(p.ws + OFF_BGT);
  bfr* dst = (bfr*)(p.ws + OFF_R1);
#pragma unroll
  for (int td = 0; td < 2; ++td)
#pragma unroll
    for (int i = 0; i < 16; ++i) {
      const int d = 32 * td + crow(i, h);
      const float g = bf2f(bg[(size_t)(hd * 64 + d) * MT + m]);
      dst[(size_t)(512 + hd * 64 + d) * MT + m] = f2bf(st.o[td][i] * inv * g);
    }
}

DI void attn_init(AttnState& st) {
#pragma unroll
  for (int td = 0; td < 2; ++td)
#pragma unroll
    for (int i = 0; i < 16; ++i) st.o[td][i] = 0.f;
  st.mrun = -INFINITY;
  st.lrun = 0.f;
}

ITEMFN void attn_na_item(const Params& p, char* smem, int item) {
  const int tid = mytid(), lane = tid & 63, wave = tid >> 6, r = lane & 31, h = lane >> 5;
  const int b = item >> 8, hd = (item >> 5) & 7, rp = item & 31;
  float* bias = (float*)(smem + 36864);
  const size_t mbase = MP + (size_t)b * 4096;
  const int r0 = 2 * rp, qr = r0 + (wave >> 1), c0 = 32 * (wave & 1);
  const int kr0 = clampi(r0 - 4, 0, 56), kr_end = clampi(r0 - 3, 0, 56) + 8;
  const int rsw = clampi(qr - 4, 0, 56);
  const int nch = 8 + (kr_end - kr0);
  __syncthreads();
  for (int idx = tid; idx < 465; idx += 256) bias[idx] = p.in[I_RELB][hd * 465 + idx] * 1.4426950408889634f;
  const size_t mq = mbase + qr * 64 + c0 + r;
  const bfr* qp = (const bfr*)(p.ws + OFF_Q) + mq * 512 + hd * 64;
  bf16x8 qf[4];
#pragma unroll
  for (int sd = 0; sd < 4; ++sd) qf[sd] = *(const bf16x8*)(qp + 16 * sd + 8 * h);
  AttnState st;
  attn_init(st);
  const bfr* ckb = (const bfr*)(p.ws + OFF_CKB) + (size_t)(b * 8 + hd) * 512 * 64;
  const bfr* cvt = (const bfr*)(p.ws + OFF_CVT) + (size_t)(b * 8 + hd) * 64 * 512;
  const bfr* kb = (const bfr*)(p.ws + OFF_K) + mbase * 512 + hd * 64;
  const bfr* vt = (const bfr*)(p.ws + OFF_VT) + (size_t)(hd * 64) * MT + mbase;
  const int qc = c0 + r, cs = clampi(qc - 8, 0, 48);
  u32x4 kreg[2], vreg[2];
  kv_gload(kreg, vreg, ckb, 64, cvt, 512, tid);
  kv_lstore(kreg, vreg, smem, smem + 9216, tid);
  __syncthreads();
#pragma unroll 1
  for (int c = 0; c < nch; ++c) {
    char* Ks = smem + (c & 1) * 18432;
    char* Vs = Ks + 9216;
    if (c + 1 < nch) {
      const int cn = c + 1;
      if (cn < 8) kv_gload(kreg, vreg, ckb + (size_t)cn * 64 * 64, 64, cvt + cn * 64, 512, tid);
      else { const int kr = kr0 + cn - 8; kv_gload(kreg, vreg, kb + (size_t)kr * 64 * 512, 512, vt + kr * 64, MT, tid); }
    }
    if (c < 8) attn_chunk<false>(st, qf, Ks, Vs, r, h, nullptr, 0, 0);
    else {
      const int kr = kr0 + c - 8;
      if (kr >= rsw && kr < rsw + 8) attn_chunk<true>(st, qf, Ks, Vs, r, h, bias + (kr - qr + 7) * 31, qc, cs);
    }
    if (c + 1 < nch) kv_lstore(kreg, vreg, smem + ((c + 1) & 1) * 18432, smem + ((c + 1) & 1) * 18432 + 9216, tid);
    __syncthreads();
  }
  attn_finish(p, st, hd, mq, h);
}

ITEMFN void attn_ctx_item(const Params& p, char* smem, int item) {
  const int tid = mytid(), lane = tid & 63, wave = tid >> 6, r = lane & 31, h = lane >> 5;
  const int b = item >> 4, hd = (item >> 1) & 7, qh = item & 1;
  const size_t mbase = (size_t)b * 256;
  const size_t mq = mbase + qh * 128 + wave * 32 + r;
  const bfr* qp = (const bfr*)(p.ws + OFF_Q) + mq * 512 + hd * 64;
  bf16x8 qf[4];
#pragma unroll
  for (int sd = 0; sd < 4; ++sd) qf[sd] = *(const bf16x8*)(qp + 16 * sd + 8 * h);
  AttnState st;
  attn_init(st);
  const bfr* kb = (const bfr*)(p.ws + OFF_K) + mbase * 512 + hd * 64;
  const bfr* vt = (const bfr*)(p.ws + OFF_VT) + (size_t)(hd * 64) * MT + mbase;
  u32x4 kreg[2], vreg[2];
  __syncthreads();
  kv_gload(kreg, vreg, kb, 512, vt, MT, tid);
  kv_lstore(kreg, vreg, smem, smem + 9216, tid);
  __syncthreads();
#pragma unroll 1
  for (int c = 0; c < 4; ++c) {
    char* Ks = smem + (c & 1) * 18432;
    char* Vs = Ks + 9216;
    if (c + 1 < 4) kv_gload(kreg, vreg, kb + (size_t)(c + 1) * 64 * 512, 512, vt + (c + 1) * 64, MT, tid);
    attn_chunk<false>(st, qf, Ks, Vs, r, h, nullptr, 0, 0);
    if (c + 1 < 4) kv_lstore(kreg, vreg, smem + ((c + 1) & 1) * 18432, smem + ((c + 1) & 1) * 18432 + 9216, tid);
    __syncthreads();
  }
  attn_finish(p, st, hd, mq, h);
}

DI void fft_fwd(cpx (&v)[16], cpx* buf, int tid) {
  __syncthreads();
  fft_fwd_pass<256, false, true>(v, buf, tid);
  __syncthreads();
  fft_fwd_pass<16, true, true>(v, buf, tid);
  __syncthreads();
  fft_fwd_pass<1, true, false>(v, buf, tid);
}
DI void fft_inv(cpx (&v)[16], cpx* buf, int tid) {
  __syncthreads();
  fft_inv_pass<1, false, true>(v, buf, tid);
  __syncthreads();
  fft_inv_pass<16, true, true>(v, buf, tid);
  __syncthreads();
  fft_inv_pass<256, true, false>(v, buf, tid);
}

DI void fft_fwd_lds(cpx (&v)[16], cpx* buf, int tid) {
  fft_fwd_pass<256, true, true>(v, buf, tid);
  __syncthreads();
  fft_fwd_pass<16, true, true>(v, buf, tid);
  __syncthreads();
  fft_fwd_pass<1, true, false>(v, buf, tid);
}
DI void fft_inv_lds(cpx (&v)[16], cpx* buf, int tid) {
  __syncthreads();
  fft_inv_pass<1, false, true>(v, buf, tid);
  __syncthreads();
  fft_inv_pass<16, true, true>(v, buf, tid);
  __syncthreads();
  fft_inv_pass<256, true, true>(v, buf, tid);
}

ITEMFN void fnet_item(const Params& p, char* smem, int item, bool prompt) {
  const int tid = mytid();
  cpx* buf = (cpx*)smem;
  float* rb = (float*)smem;
  const int sb = item / 260, rem = item - sb * 260, g = rem / 65, k2 = rem - g * 65;
  const size_t mbase = prompt ? (size_t)sb * 4096 : MP + (size_t)sb * 4096;
  const bool has_im = (k2 != 0) && (k2 != 64);
  const bfr* re = (const bfr*)(p.ws + OFF_R2) + (size_t)(g * 128 + k2) * MT + mbase;
  const bfr* im = (const bfr*)(p.ws + OFF_R2) + (size_t)(g * 128 + 64 + (has_im ? k2 : 1)) * MT + mbase;
  cpx v[16];
  float scale;
  if (!prompt) {
#pragma unroll
    for (int jj = 0; jj < 16; ++jj) { v[jj].x = bf2f(re[tid + 256 * jj]); v[jj].y = has_im ? bf2f(im[tid + 256 * jj]) : 0.f; }
    fft_fwd(v, buf, tid);
    __syncthreads();
    scale = 0.0013810679320049757f;
#pragma unroll
    for (int k = 0; k < 16; ++k) { const int idx = k * 256 + (tid & 15) * 16 + (tid >> 4); rb[idx + (idx >> 4)] = v[k].x * scale; }
  } else {
    const int base = (tid >> 4) * 256 + (tid & 15);
#pragma unroll
    for (int jj = 0; jj < 16; ++jj) { v[jj].x = bf2f(re[base + 16 * jj]); v[jj].y = has_im ? bf2f(im[base + 16 * jj]) : 0.f; }
    __syncthreads();
    fft_fwd_pass<16, false, true>(v, buf, tid);
    __syncthreads();
    fft_fwd_pass<1, true, false>(v, buf, tid);
    __syncthreads();
    scale = 0.005524271728019903f;
#pragma unroll
    for (int k = 0; k < 16; ++k) { const int idx = (tid >> 4) * 256 + k * 16 + (tid & 15); rb[idx + (idx >> 4)] = v[k].x * scale; }
  }
  __syncthreads();
  const int lmask = prompt ? 255 : 4095;
  {
    const int j1 = g * 128 + k2;
    const bfr* ag = (const bfr*)(p.ws + OFF_AGT) + (size_t)j1 * MT + mbase;
    bfr* dst = (bfr*)(p.ws + OFF_R1) + (size_t)j1 * MT + mbase;
#pragma unroll
    for (int i = 0; i < 2; ++i) {
      const int q0 = 8 * (tid + 256 * i);
      u32x4 a = *(const u32x4*)(ag + q0);
      const unsigned au[4] = {a.x, a.y, a.z, a.w};
      float f[8];
#pragma unroll
      for (int e = 0; e < 8; ++e) {
        const float gv = (e & 1) ? __uint_as_float(au[e >> 1] & 0xffff0000u) : __uint_as_float(au[e >> 1] << 16);
        f[e] = rb[q0 + (q0 >> 4) + e] * gv;
      }
      u32x4 o; o.x = pk2(f[0], f[1]); o.y = pk2(f[2], f[3]); o.z = pk2(f[4], f[5]); o.w = pk2(f[6], f[7]);
      *(u32x4*)(dst + q0) = o;
    }
  }
  if (has_im) {
    const int j2 = g * 128 + 128 - k2;
    const bfr* ag = (const bfr*)(p.ws + OFF_AGT) + (size_t)j2 * MT + mbase;
    bfr* dst = (bfr*)(p.ws + OFF_R1) + (size_t)j2 * MT + mbase;
#pragma unroll
    for (int i = 0; i < 2; ++i) {
      const int q0 = 8 * (tid + 256 * i);
      u32x4 a = *(const u32x4*)(ag + q0);
      const unsigned au[4] = {a.x, a.y, a.z, a.w};
      float f[8];
#pragma unroll
      for (int e = 0; e < 8; ++e) {
        const float gv = (e & 1) ? __uint_as_float(au[e >> 1] & 0xffff0000u) : __uint_as_float(au[e >> 1] << 16);
        const int k1 = q0 + e;
        const int src = (k1 & ~lmask) | ((lmask + 1 - (k1 & lmask)) & lmask);
        f[e] = rb[src + (src >> 4)] * gv;
      }
      u32x4 o; o.x = pk2(f[0], f[1]); o.y = pk2(f[2], f[3]); o.z = pk2(f[4], f[5]); o.w = pk2(f[6], f[7]);
      *(u32x4*)(dst + q0) = o;
    }
  }
  __syncthreads();
}

DI float conv3(const bfr* row, int n, int L, float w0, float w1, float w2, float bias) {
  const float a = n > 0 ? bf2f(row[n - 1]) : 0.f;
  const float b = bf2f(row[n]);
  const float c = n < L - 1 ? bf2f(row[n + 1]) : 0.f;
  return a * w0 + b * w1 + c * w2 + bias;
}

DI void stage_rows(bfr* l0, bfr* l1, const bfr* g0, const bfr* g1, int tid) {
#pragma unroll
  for (int i = 0; i < 2; ++i) {
    const int ch = tid + 256 * i;
    const u32x4 a = *(const u32x4*)(g0 + 8 * ch);
    const u32x4 b = *(const u32x4*)(g1 + 8 * ch);
    *(u32x4*)(l0 + 8 * ch) = a;
    *(u32x4*)(l1 + 8 * ch) = b;
  }
}
DI float conv3l(const bfr* row, int n, float w0, float w1, float w2, float bias) {
  const float a = bf2f(row[n > 0 ? n - 1 : 0]);
  const float b = bf2f(row[n]);
  const float c = bf2f(row[n < 4095 ? n + 1 : 4095]);
  return (n > 0 ? a : 0.f) * w0 + b * w1 + (n < 4095 ? c : 0.f) * w2 + bias;
}

ITEMFN void hyena_sample_item(const Params& p, char* smem, int c) {
  const int tid = mytid();
  cpx* buf = (cpx*)smem;
  bfr* raw0 = (bfr*)smem;
  bfr* raw1 = (bfr*)(smem + 8192);
  bfr* raw2 = (bfr*)(smem + 16384);
  bfr* raw3 = (bfr*)(smem + 24576);
  const float* scw = p.in[I_SCW];
  const float* scb = p.in[I_SCB];
  bfr* proj = (bfr*)(p.ws + OFF_BIG);
  bfr* P0 = proj + (size_t)c * MT + MP;
  bfr* P1 = proj + (size_t)(1024 + c) * MT + MP;
  const bfr* P2 = proj + (size_t)(2048 + c) * MT + MP;
  const bfr* PG = proj + (size_t)(3072 + c) * MT + MP;
  bfr* dst = (bfr*)(p.ws + OFF_R2) + (size_t)c * MT + MP;
  const float* fsum = (const float*)(p.ws + OFF_FSUM) + 2 * 1024;
  const float* F = (const float*)(p.ws + OFF_F4096);
#pragma unroll 1
  for (int order = 0; order < 2; ++order) {
    const float* hf = F + ((size_t)(0 * 2 + order) * 1024 + c) * 4096;
    const float* hb = F + ((size_t)(1 * 2 + order) * 1024 + c) * 4096;
    const float skip = p.in[I_FSKIP][order * 1024 + c];
    const int col1 = (order + 1) * 1024 + c;
    const float a0 = scw[c], a1 = scw[3072 + c], a2 = scw[6144 + c], ab = scb[c];
    const float m0 = scw[col1], m1 = scw[3072 + col1], m2 = scw[6144 + col1], mb = scb[col1];
    const bfr* PM = order == 0 ? P1 : P2;
    unsigned* ysc = order == 0 ? (unsigned*)dst : (unsigned*)P1;
    cpx G[16];
    {
    const float inv = 1.f / (fsum[order * 1024 + c] + 1e-6f);
    int tt = tid; OPAQUE(tt);
#pragma unroll
    for (int j = 0; j < 16; ++j) {
      const unsigned n = (unsigned)tt + 256u * j;
      const float a = hf[n] * inv + (n == 0u ? skip : 0.f);
      const float bq = n >= 1u ? hb[4096u - n] * inv : 0.f;
      G[j].x = a + bq; G[j].y = 0.f;
    }
    }
    fft_fwd(G, buf, tid);
#pragma unroll 1
    for (int pp = 0; pp < 4; ++pp) {
      int tq = tid; OPAQUE(tq);
      const bfr* r0 = P0 + (size_t)(2 * pp) * 4096;
      const bfr* r1 = P0 + (size_t)(2 * pp + 1) * 4096;
      cpx w[16];
      __syncthreads();
      stage_rows(raw0, raw1, r0, r1, tq);
      __syncthreads();
#pragma unroll
      for (int j = 0; j < 16; ++j) {
        const int n = tq + 256 * j;
        if (order == 0) { w[j].x = conv3l(raw0, n, a0, a1, a2, ab); w[j].y = conv3l(raw1, n, a0, a1, a2, ab); }
        else { w[j].x = bf2f(raw0[n]); w[j].y = bf2f(raw1[n]); }
      }
      fft_fwd(w, buf, tq);
#pragma unroll
      for (int k = 0; k < 16; ++k) w[k] = cmul(w[k], G[k]);
      fft_inv(w, buf, tq);
#pragma unroll
      for (int j = 0; j < 16; ++j) ysc[pp * 4096 + tq + 256 * j] = pk2(w[j].x * (1.f / 8192.f), w[j].y * (1.f / 8192.f));
    }
    {
    const float inv = 1.f / (fsum[order * 1024 + c] + 1e-6f);
    int tt = tid; OPAQUE(tt);
#pragma unroll
    for (int j = 0; j < 16; ++j) {
      const unsigned n = (unsigned)tt + 256u * j;
      const float a = hf[n] * inv + (n == 0u ? skip : 0.f);
      const float bq = n >= 1u ? hb[4096u - n] * inv : 0.f;
      float s, cs;
      SINCOSPI((float)n * (1.f / 4096.f), &s, &cs);
      const float d = a - bq;
      G[j].x = d * cs; G[j].y = -d * s;
    }
    }
    fft_fwd(G, buf, tid);
#pragma unroll 1
    for (int pp = 0; pp < 4; ++pp) {
      int tq = tid; OPAQUE(tq);
      bfr* r0 = P0 + (size_t)(2 * pp) * 4096;
      bfr* r1 = P0 + (size_t)(2 * pp + 1) * 4096;
      cpx w[16];
      __syncthreads();
      stage_rows(raw0, raw1, r0, r1, tq);
      __syncthreads();
#pragma unroll
      for (int j = 0; j < 16; ++j) {
        const int n = tq + 256 * j;
        cpx z;
        if (order == 0) { z.x = conv3l(raw0, n, a0, a1, a2, ab); z.y = conv3l(raw1, n, a0, a1, a2, ab); }
        else { z.x = bf2f(raw0[n]); z.y = bf2f(raw1[n]); }
        float s, cs;
        { int no = n; OPAQUE(no); SINCOSPI((float)no * (1.f / 4096.f), &s, &cs); }
        cpx tw; tw.x = cs; tw.y = -s;
        w[j] = cmul(z, tw);
      }
      fft_fwd(w, buf, tq);
#pragma unroll
      for (int k = 0; k < 16; ++k) w[k] = cmul(w[k], G[k]);
      fft_inv(w, buf, tq);
      unsigned ye[16];
#pragma unroll
      for (int j = 0; j < 16; ++j) ye[j] = ysc[pp * 4096 + tq + 256 * j];
      __syncthreads();
      stage_rows(raw0, raw1, PM + (size_t)(2 * pp) * 4096, PM + (size_t)(2 * pp + 1) * 4096, tq);
      if (order == 1) stage_rows(raw2, raw3, PG + (size_t)(2 * pp) * 4096, PG + (size_t)(2 * pp + 1) * 4096, tq);
      __syncthreads();
      bfr* o0 = order == 0 ? r0 : dst + (size_t)(2 * pp) * 4096;
      bfr* o1 = order == 0 ? r1 : dst + (size_t)(2 * pp + 1) * 4096;
#pragma unroll
      for (int j = 0; j < 16; ++j) {
        const int n = tq + 256 * j;
        float s, cs;
        { int no = n; OPAQUE(no); SINCOSPI((float)no * (1.f / 4096.f), &s, &cs); }
        cpx tw; tw.x = cs; tw.y = -s;
        const cpx yo = cmulc(w[j], tw);
        const float yx = __uint_as_float(ye[j] << 16) + yo.x * (1.f / 8192.f);
        const float yy = __uint_as_float(ye[j] & 0xffff0000u) + yo.y * (1.f / 8192.f);
        const float ux = conv3l(raw0, n, m0, m1, m2, mb);
        const float uy = conv3l(raw1, n, m0, m1, m2, mb);
        const float g0 = order == 0 ? 1.f : siluf(bf2f(raw2[n]));
        const float g1 = order == 0 ? 1.f : siluf(bf2f(raw3[n]));
        o0[n] = f2bf(ux * yx * g0);
        o1[n] = f2bf(uy * yy * g1);
      }
    }
    __syncthreads();
  }
}

ITEMFN void hyena_prompt_item(const Params& p, char* smem, int c) {
  const int tid = mytid();
  cpx* buf = (cpx*)smem;
  const float* scw = p.in[I_SCW];
  const float* scb = p.in[I_SCB];
  bfr* proj = (bfr*)(p.ws + OFF_BIG);
  bfr* P0 = proj + (size_t)c * MT;
  const bfr* P1 = proj + (size_t)(1024 + c) * MT;
  const bfr* P2 = proj + (size_t)(2048 + c) * MT;
  const bfr* PG = proj + (size_t)(3072 + c) * MT;
  bfr* dst = (bfr*)(p.ws + OFF_R2) + (size_t)c * MT;
  const float* fsum = (const float*)(p.ws + OFF_FSUM);
  const float* F = (const float*)(p.ws + OFF_F256);
#pragma unroll 1
  for (int order = 0; order < 2; ++order) {
    cpx G[16];
#pragma unroll
    for (int j = 0; j < 16; ++j) { G[j].x = 0.f; G[j].y = 0.f; }
    const float inv = 1.f / (fsum[order * 1024 + c] + 1e-6f);
    G[0].x = F[((size_t)(0 * 2 + order) * 1024 + c) * 256 + tid] * inv;
    if (tid >= 1) G[15].x = F[((size_t)(1 * 2 + order) * 1024 + c) * 256 + 256 - tid] * inv;
    fft_fwd(G, buf, tid);
    const float skip = p.in[I_FSKIP][order * 1024 + c];
    const int col1 = (order + 1) * 1024 + c;
    const float a0 = scw[c], a1 = scw[3072 + c], a2 = scw[6144 + c], ab = scb[c];
    const float m0 = scw[col1], m1 = scw[3072 + col1], m2 = scw[6144 + col1], mb = scb[col1];
    const bfr* PM = order == 0 ? P1 : P2;
#pragma unroll 1
    for (int cc = 0; cc < 2; ++cc) {
      cpx zr[8], w[16];
#pragma unroll
      for (int j = 0; j < 16; ++j) {
        if ((j & 1) == 0) {
          const size_t o0 = (size_t)(16 * cc + (j >> 1)) * 256, o1 = (size_t)(16 * cc + 8 + (j >> 1)) * 256;
          if (order == 0) { zr[j >> 1].x = conv3(P0 + o0, tid, 256, a0, a1, a2, ab); zr[j >> 1].y = conv3(P0 + o1, tid, 256, a0, a1, a2, ab); }
          else { zr[j >> 1].x = bf2f(P0[o0 + tid]); zr[j >> 1].y = bf2f(P0[o1 + tid]); }
          w[j] = zr[j >> 1];
        } else { w[j].x = 0.f; w[j].y = 0.f; }
      }
      fft_fwd(w, buf, tid);
#pragma unroll
      for (int k = 0; k < 16; ++k) w[k] = cmul(w[k], G[k]);
      fft_inv(w, buf, tid);
#pragma unroll
      for (int j = 0; j < 16; j += 2) {
        const size_t o0 = (size_t)(16 * cc + (j >> 1)) * 256, o1 = (size_t)(16 * cc + 8 + (j >> 1)) * 256;
        const float yx = w[j].x * (1.f / 4096.f) + skip * zr[j >> 1].x;
        const float yy = w[j].y * (1.f / 4096.f) + skip * zr[j >> 1].y;
        const float ux = conv3(PM + o0, tid, 256, m0, m1, m2, mb);
        const float uy = conv3(PM + o1, tid, 256, m0, m1, m2, mb);
        if (order == 0) {
          P0[o0 + tid] = f2bf(ux * yx);
          P0[o1 + tid] = f2bf(uy * yy);
        } else {
          const float g0 = siluf(bf2f(PG[o0 + tid]));
          const float g1 = siluf(bf2f(PG[o1 + tid]));
          dst[o0 + tid] = f2bf(ux * yx * g0);
          dst[o1 + tid] = f2bf(uy * yy * g1);
        }
      }
    }
    __syncthreads();
  }
}


DI void p0_light(const Params& p, char* smem, int it) {
  if (it < 320) p0_fold(p, smem, it - 192);
  else if (it < 592) p0_hid(p, smem, it - 320);
  else if (it < 2768) p0_transpose(p, smem, it - 592);
  else p0_cache(p, smem, it - 2768);
}

#define XB_TMO      128
#define XB_XCNT(j)  (256  + 64 * (j))
#define XB_XSUB(j)  (1280 + 64 * (j))
#define XB_XGEN(j)  (2304 + 64 * (j))
#define XB_TOP      3328
#define XB_TOPGEN   3392
#define XCD_BAR_WORDS 3456
#define XB_SPIN_CAP (1u << 18)
#define LAS __attribute__((address_space(3)))
__device__ __forceinline__ unsigned xb_ld(unsigned* p)              { return __hip_atomic_load(p, __ATOMIC_RELAXED, __HIP_MEMORY_SCOPE_AGENT); }
__device__ __forceinline__ unsigned xb_add(unsigned* p, unsigned v) { return __hip_atomic_fetch_add(p, v, __ATOMIC_RELAXED, __HIP_MEMORY_SCOPE_AGENT); }
__device__ __forceinline__ unsigned xb_xcc_id() { return (unsigned)__builtin_amdgcn_s_getreg((3 << 11) | 20) & 0xFu; }
#define XB_SPIN(cond, bar) do { unsigned _sp = 0; while (cond) { __builtin_amdgcn_s_sleep(1); \
    if ((++_sp & 255u) == 0u) { if (xb_ld(&(bar)[XB_TMO])) break; if (_sp > XB_SPIN_CAP) { atomicAdd(&(bar)[XB_TMO], 1u); break; } } } } while (0)
struct XcdBarrier { unsigned* bar; unsigned x; volatile LAS unsigned* st; };
__device__ __forceinline__ XcdBarrier xcd_barrier_post(unsigned* bar, volatile LAS unsigned* st) {
    XcdBarrier b; b.bar = bar; b.x = xb_xcc_id(); b.st = st;
    if (threadIdx.x == 0) (void)xb_add(&bar[XB_XCNT(b.x)], 1u);
    return b;
}
__device__ __forceinline__ void xcd_barrier_complete(unsigned* bar, unsigned x, unsigned& nloc, unsigned& nx) {
    const unsigned G = gridDim.x * gridDim.y * gridDim.z;
    unsigned sum, cnt, mine, sp = 0u;
    for (;;) {
        sum = 0u; cnt = 0u; mine = 0u;
#pragma unroll
        for (unsigned j = 0; j < 16; ++j) { const unsigned c = xb_ld(&bar[XB_XCNT(j)]); sum += c; cnt += (c > 0u) ? 1u : 0u; mine = (j == x) ? c : mine; }
        if (sum == G) break;
        __builtin_amdgcn_s_sleep(1);
        if ((++sp & 255u) == 0u) { if (xb_ld(&bar[XB_TMO])) break; if (sp > XB_SPIN_CAP) { atomicAdd(&bar[XB_TMO], 1u); break; } }
    }
    nloc = mine > 0u ? mine : 1u; nx = cnt > 0u ? cnt : 1u;
}
__device__ __forceinline__ void xcd_barrier(const XcdBarrier& b) {
    asm volatile("s_waitcnt vmcnt(0)" ::: "memory");
    __syncthreads();
    if (threadIdx.x == 0) {
        unsigned* bar = b.bar;
        __builtin_amdgcn_s_waitcnt(0);
        unsigned nloc = b.st[0], nx = b.st[1];
        if (nloc == 0u) { xcd_barrier_complete(bar, b.x, nloc, nx); b.st[0] = nloc; b.st[1] = nx; }
        const unsigned old = xb_add(&bar[XB_XSUB(b.x)], 1u);
        const unsigned gen = old / nloc;
        if (old + 1u == (gen + 1u) * nloc) {
            __builtin_amdgcn_fence(__ATOMIC_RELEASE, "agent");
            asm volatile("s_waitcnt vmcnt(0)" ::: "memory");
            const unsigned og = xb_add(&bar[XB_TOP], 1u);
            const unsigned tg = og / nx;
            if (og + 1u == (tg + 1u) * nx) xb_add(&bar[XB_TOPGEN], 1u);
            else XB_SPIN(xb_ld(&bar[XB_TOPGEN]) == tg, bar);
            __builtin_amdgcn_fence(__ATOMIC_ACQUIRE, "agent");
            xb_add(&bar[XB_XGEN(b.x)], 1u);
            asm volatile("s_waitcnt vmcnt(0)" ::: "memory");
        } else {
            XB_SPIN(xb_ld(&bar[XB_XGEN(b.x)]) == gen, bar);
            __builtin_amdgcn_fence(__ATOMIC_ACQUIRE, "agent");
            asm volatile("s_waitcnt vmcnt(0)" ::: "memory");
        }
    }
    __syncthreads();
}

__global__ void __launch_bounds__(256, 2) mega(Params p, int ph_lo, int ph_hi) {
  __shared__ __attribute__((aligned(16))) char smem[49152];
  __shared__ u32x4 xb_words;
  if (threadIdx.x == 0) xb_words = u32x4{0u, 0u, 0u, 0u};
  __syncthreads();
  if (ph_lo > 4096) cg::this_grid().sync();
  const XcdBarrier xb = xcd_barrier_post((unsigned*)(p.ws + OFF_BAR), (volatile LAS unsigned*)&xb_words);
  const int bid = blockIdx.x, nb = gridDim.x;
#pragma unroll
  for (int ph = 0; ph < NPH; ++ph) {
    if (ph < ph_lo || ph >= ph_hi) continue;
    if (ph > ph_lo) {
      xcd_barrier(xb);
    }
#pragma unroll
    for (int rep = 0; rep < 1 + ((DUP_MASK >> ph) & 1); ++rep)
    switch (ph) {
      case 0:
        if (nb == 512) {
          if (bid < 192) p0_mod(p, smem, bid);
          else for (int r = 0; r < 3; ++r) p0_light(p, smem, 192 + (bid - 192) + 320 * r);
          for (int it = 192 + 960 + bid; it < 3280; it += 512) p0_light(p, smem, it);
        } else {
          for (int it = bid; it < 3280; it += nb) {
            if (it < 192) p0_mod(p, smem, it);
            else p0_light(p, smem, it);
          }
        }
        break;
      case 1:
        for (int it = bid; it < 1024 + 2560; it += nb) {
          if (it < 1024) filt_item(p, smem, 1023 - it);
          else norm_item(p, it - 1024, 0);
        }
        break;
      case 2:
        if ((nb & 7) == 0) { for (int lt = bid >> 3; lt < 40 * 12; lt += nb >> 3) { int mt, nt; tile_map<12, 4>(lt, bid & 7, mt, nt); inproj0_tile(p, smem, mt, nt); } }
        else { for (int t = bid; t < 320 * 12; t += nb) inproj0_tile(p, smem, t / 12, t % 12); }
        break;
      case 3:
        for (int k = 0; bid + k * nb < 5160; ++k) {
          const int cnt = (5160 - bid + nb - 1) / nb;
          const int it = bid + ((bid >= (nb >> 1)) ? (cnt - 1 - k) : k) * nb;
          if (it < 2048) attn_na_item(p, smem, it);
          else if (it < 2560) attn_ctx_item(p, smem, it - 2048);
          else if (it < 4640) fnet_item(p, smem, it - 2560, false);
          else fnet_item(p, smem, it - 4640, true);
        }
        break;
      case 4:
        for (int it = bid; it < 10240; it += nb) xpose_item(p, smem, it, 0);
        break;
      case 5:
        if ((nb & 7) == 0) { for (int lt = bid >> 3; lt < 40 * 8; lt += nb >> 3) { int mt, nt; tile_map<8, 8>(lt, bid & 7, mt, nt); outproj_tile(p, smem, mt, nt, 0); } }
        else { for (int t = bid; t < 320 * 8; t += nb) outproj_tile(p, smem, t >> 3, t & 7, 0); }
        break;
      case 6:
        for (int it = bid; it < 2560; it += nb) norm_item(p, it, 1);
        break;
      case 7:
        if ((nb & 7) == 0) { for (int lt = bid >> 3; lt < 40 * 16; lt += nb >> 3) { int mt, nt; tile_map<16, 8>(lt, bid & 7, mt, nt); inproj1_tile(p, smem, mt, nt); } }
        else { for (int t = bid; t < 320 * 16; t += nb) inproj1_tile(p, smem, t >> 4, t & 15); }
        break;
      case 8:
        for (int it = bid; it < 2048; it += nb) {
          if (it < 1024) hyena_sample_item(p, smem, it);
          else hyena_prompt_item(p, smem, it - 1024);
        }
        break;
      case 9:
        for (int it = bid; it < 10240; it += nb) xpose_item(p, smem, it, 1);
        break;
      case 10:
        if ((nb & 7) == 0) { for (int lt = bid >> 3; lt < 40 * 8; lt += nb >> 3) { int mt, nt; tile_map<8, 8>(lt, bid & 7, mt, nt); outproj_tile(p, smem, mt, nt, 1); } }
        else { for (int t = bid; t < 320 * 8; t += nb) outproj_tile(p, smem, t >> 3, t & 7, 1); }
        break;
    }
  }
}

extern "C" void kernel_launch(void* const* d_in, const int* in_sizes, int n_in, void* d_out, int out_size, void* d_ws,
                              size_t ws_size, hipStream_t stream) {
  Params p{};
  for (int i = 0; i < 29; ++i) p.in[i] = (const float*)d_in[i];
  p.out = (float*)d_out;
  p.ws = (char*)d_ws;
  if (ws_size < WS_NEEDED) { fprintf(stderr, "workspace too small: %zu < %zu\n", ws_size, (size_t)WS_NEEDED); return; }
  static int grid_blocks = 0;
  if (!grid_blocks) {
    int dev = 0, cus = 0, per_cu = 0;
    hipGetDevice(&dev);
    hipDeviceGetAttribute(&cus, hipDeviceAttributeMultiprocessorCount, dev);
    hipOccupancyMaxActiveBlocksPerMultiprocessor(&per_cu, mega, 256, 0);
    if (per_cu > 2) per_cu = 2;
    grid_blocks = cus * per_cu;
  }
  hipMemsetAsync((char*)d_ws + OFF_BAR, 0, 16384, stream);
#if SINGLE_LAUNCH
  int lo = 0, hi = NPH;
  void* args[] = {&p, &lo, &hi};
  hipError_t e = hipLaunchCooperativeKernel((void*)mega, dim3(grid_blocks), dim3(256), args, 0, stream);
  if (e != hipSuccess) fprintf(stderr, "cooperative launch failed: %s (grid %d)\n", hipGetErrorString(e), grid_blocks);
#else
  for (int ph = 0; ph < NPH; ++ph) mega<<<grid_blocks, 256, 0, stream>>>(p, ph, ph + 1);
#endif
}
```

```cpp
#include <hip/hip_runtime.h>
#include <hip/hip_cooperative_groups.h>
#include <cstdio>
namespace cg = cooperative_groups;

#ifndef DUP_MASK
#define DUP_MASK 0
#endif
#ifndef SINGLE_LAUNCH
#define SINGLE_LAUNCH 1
#endif

#define DI __device__ __forceinline__
#define HD __device__ __forceinline__
#define SINCOSPI(x, s, c) do { *(s) = __builtin_amdgcn_sinf(0.5f * (x)); *(c) = __builtin_amdgcn_cosf(0.5f * (x)); } while (0)
#define OPAQUE(x) asm volatile("" : "+v"(x))
#ifdef DIAG_NOINLINE
#define ITEMFN __device__ __attribute__((noinline))
#else
#define ITEMFN __device__ __forceinline__
#endif

struct cpx { float x, y; };
HD cpx cmul(cpx a, cpx b) { cpx r; r.x = a.x * b.x - a.y * b.y; r.y = a.x * b.y + a.y * b.x; return r; }
HD cpx cmulc(cpx a, cpx b) { cpx r; r.x = a.x * b.x + a.y * b.y; r.y = a.y * b.x - a.x * b.y; return r; }
HD cpx cadd(cpx a, cpx b) { cpx r; r.x = a.x + b.x; r.y = a.y + b.y; return r; }
HD cpx csub(cpx a, cpx b) { cpx r; r.x = a.x - b.x; r.y = a.y - b.y; return r; }
template <bool INV> HD cpx mulmi(cpx a) { cpx r; if (!INV) { r.x = a.y; r.y = -a.x; } else { r.x = -a.y; r.y = a.x; } return r; }
template <bool INV> HD void dft4(cpx& a0, cpx& a1, cpx& a2, cpx& a3) {
  cpx s02 = cadd(a0, a2), d02 = csub(a0, a2), s13 = cadd(a1, a3), d13 = mulmi<INV>(csub(a1, a3));
  a0 = cadd(s02, s13); a2 = csub(s02, s13); a1 = cadd(d02, d13); a3 = csub(d02, d13);
}
template <bool INV> HD cpx twc(cpx a, float c, float s) {
  cpx r; if (!INV) { r.x = a.x * c + a.y * s; r.y = a.y * c - a.x * s; } else { r.x = a.x * c - a.y * s; r.y = a.y * c + a.x * s; } return r;
}
template <bool INV> HD void dft16(cpx (&v)[16]) {
#pragma unroll
  for (int b = 0; b < 4; ++b) dft4<INV>(v[b], v[4 + b], v[8 + b], v[12 + b]);
  const float C1 = 0.92387953251128674f, S1 = 0.38268343236508977f, R2 = 0.70710678118654752f;
  v[4 * 1 + 1] = twc<INV>(v[4 * 1 + 1], C1, S1);
  v[4 * 2 + 1] = twc<INV>(v[4 * 2 + 1], R2, R2);
  v[4 * 3 + 1] = twc<INV>(v[4 * 3 + 1], S1, C1);
  v[4 * 1 + 2] = twc<INV>(v[4 * 1 + 2], R2, R2);
  v[4 * 2 + 2] = mulmi<INV>(v[4 * 2 + 2]);
  v[4 * 3 + 2] = twc<INV>(v[4 * 3 + 2], -R2, R2);
  v[4 * 1 + 3] = twc<INV>(v[4 * 1 + 3], S1, C1);
  v[4 * 2 + 3] = twc<INV>(v[4 * 2 + 3], -R2, R2);
  v[4 * 3 + 3] = twc<INV>(v[4 * 3 + 3], -C1, -S1);
#pragma unroll
  for (int c = 0; c < 4; ++c) dft4<INV>(v[4 * c + 0], v[4 * c + 1], v[4 * c + 2], v[4 * c + 3]);
#pragma unroll
  for (int c = 0; c < 4; ++c)
#pragma unroll
    for (int d = c + 1; d < 4; ++d) { cpx t = v[4 * c + d]; v[4 * c + d] = v[4 * d + c]; v[4 * d + c] = t; }
}
HD int PADI(int p) { return p + (p >> 4); }
template <bool INV> HD void twiddle16(cpx (&v)[16], float c1, float s1) {
  cpx w[16];
  w[1].x = c1; w[1].y = INV ? s1 : -s1;
  w[2] = cmul(w[1], w[1]); w[3] = cmul(w[2], w[1]); w[4] = cmul(w[2], w[2]);
  w[5] = cmul(w[4], w[1]); w[6] = cmul(w[4], w[2]); w[7] = cmul(w[4], w[3]); w[8] = cmul(w[4], w[4]);
#pragma unroll
  for (int k = 9; k < 16; ++k) w[k] = cmul(w[8], w[k - 8]);
#pragma unroll
  for (int k = 1; k < 16; ++k) v[k] = cmul(v[k], w[k]);
}
template <int S, bool LOAD, bool STORE> HD void fft_fwd_pass(cpx (&v)[16], cpx* buf, int tid) {
  OPAQUE(tid);
  const int n1 = tid & (S - 1), hi = tid / S, base = hi * 16 * S + n1;
  cpx* bp = buf + PADI(base);
  constexpr int STR = S == 1 ? 1 : S + S / 16;
  if (LOAD) {
#pragma unroll
    for (int j = 0; j < 16; ++j) v[j] = bp[STR * j];
  }
  dft16<false>(v);
  if (S > 1) { int n1o = n1; OPAQUE(n1o); float s, c; SINCOSPI(2.0f * (float)n1o / (float)(16 * S), &s, &c); twiddle16<false>(v, c, s); }
  if (STORE) {
#pragma unroll
    for (int j = 0; j < 16; ++j) bp[STR * j] = v[j];
  }
}
template <int S, bool LOAD, bool STORE> HD void fft_inv_pass(cpx (&v)[16], cpx* buf, int tid) {
  OPAQUE(tid);
  const int n1 = tid & (S - 1), hi = tid / S, base = hi * 16 * S + n1;
  cpx* bp = buf + PADI(base);
  constexpr int STR = S == 1 ? 1 : S + S / 16;
  if (LOAD) {
#pragma unroll
    for (int j = 0; j < 16; ++j) v[j] = bp[STR * j];
  }
  if (S > 1) { int n1o = n1; OPAQUE(n1o); float s, c; SINCOSPI(2.0f * (float)n1o / (float)(16 * S), &s, &c); twiddle16<true>(v, c, s); }
  dft16<true>(v);
  if (STORE) {
#pragma unroll
    for (int j = 0; j < 16; ++j) bp[STR * j] = v[j];
  }
}


typedef unsigned short bfr;
using bf16x8 = __attribute__((ext_vector_type(8))) short;
using s16x4 = __attribute__((ext_vector_type(4))) short;
using f32x16 = __attribute__((ext_vector_type(16))) float;
using u32x4 = __attribute__((ext_vector_type(4))) unsigned;
using u32x2 = __attribute__((ext_vector_type(2))) unsigned;
using f32x4 = __attribute__((ext_vector_type(4))) float;
#define SB() __builtin_amdgcn_sched_barrier(0)
#define MFMA(a, b, c) __builtin_amdgcn_mfma_f32_32x32x16_bf16((a), (b), (c), 0, 0, 0)

constexpr int MT = 40960;
constexpr int MP = 8192;
constexpr int NPH = 11;

enum { I_XP = 0, I_XS, I_CK, I_CV, I_C, I_CCTX, I_NORM0G, I_MOD0W, I_MOD0B, I_IN0W, I_QNG, I_KNG, I_RELB, I_OUT0W,
       I_NORM1G, I_MOD1W, I_MOD1B, I_IN1W, I_SCW, I_SCB, I_FW1, I_FB1, I_FFR1, I_FW2, I_FB2, I_FFR2, I_FW3, I_FSKIP, I_OUT1W };

struct Params {
  const float* in[29];
  float* out;
  char* ws;
};

constexpr size_t OFF_W0T = 0;
constexpr size_t OFF_WO0T = 7340032;
constexpr size_t OFF_W1T = 9437184;
constexpr size_t OFF_WO1T = 17825792;
constexpr size_t OFF_MOD = 19922944;
constexpr size_t OFF_CKB = 20144128;
constexpr size_t OFF_CVT = 24338432;
constexpr size_t OFF_HID = 28532736;
constexpr size_t OFF_FSUM = 29646848;
constexpr size_t OFF_F256 = 29663232;
constexpr size_t OFF_F4096 = 33857536;
constexpr size_t OFF_R2 = 100966400;
constexpr size_t OFF_BIG = 184852480;
constexpr size_t OFF_R1 = OFF_BIG;
constexpr size_t OFF_AGT = OFF_BIG + 83886080;
constexpr size_t OFF_Q = OFF_BIG + 125829120;
constexpr size_t OFF_K = OFF_BIG + 167772160;
constexpr size_t OFF_VT = OFF_BIG + 209715200;
constexpr size_t OFF_BGT = OFF_BIG + 251658240;
constexpr size_t OFF_BAR = OFF_BIG + 335544320;
constexpr size_t WS_NEEDED = OFF_BAR + 16384;

constexpr size_t OUT_K = 41943040;
constexpr size_t OUT_V = 46137344;

DI int mytid() { int t = __builtin_amdgcn_workitem_id_x(); OPAQUE(t); return t; }
typedef __bf16 bf16x2_t __attribute__((ext_vector_type(2)));
DI bfr f2bf(float x) { __bf16 v = (__bf16)x; return __builtin_bit_cast(bfr, v); }
DI float bf2f(bfr b) { return __uint_as_float(((unsigned)b) << 16); }
DI unsigned pk2(float a, float b) { bf16x2_t v = {(__bf16)a, (__bf16)b}; return __builtin_bit_cast(unsigned, v); }
DI float siluf(float v) { return v * __builtin_amdgcn_rcpf(1.f + __builtin_amdgcn_exp2f(-1.4426950408889634f * v)); }
DI int crow(int i, int h) { return (i & 3) + 8 * (i >> 2) + 4 * h; }
DI int clampi(int v, int lo, int hi) { return v < lo ? lo : (v > hi ? hi : v); }

ITEMFN void p0_mod(const Params& p, char* smem, int item) {
  const int tid = mytid();
  const int layer = item / 96, nb = item % 96;
  float* sl = (float*)smem;
  float* red = sl;
  const float* c = p.in[I_C];
  const float* cc = p.in[I_CCTX];
  for (int idx = tid; idx < 9 * 1024; idx += 256) {
    int ci = idx >> 10, k = idx & 1023;
    float v = ci < 8 ? c[ci * 1024 + k] : cc[k];
    sl[idx] = v / (1.f + expf(-v));
  }
  __syncthreads();
  const float* W = (layer ? p.in[I_MOD1W] : p.in[I_MOD0W]);
  const float* B = (layer ? p.in[I_MOD1B] : p.in[I_MOD0B]);
  const int kg = tid >> 5, col = tid & 31, n = nb * 32 + col;
  float acc[9];
#pragma unroll
  for (int ci = 0; ci < 9; ++ci) acc[ci] = 0.f;
#pragma unroll 4
  for (int k = kg * 128; k < kg * 128 + 128; ++k) {
    float w = W[(size_t)k * 3072 + n];
#pragma unroll
    for (int ci = 0; ci < 9; ++ci) acc[ci] += sl[ci * 1024 + k] * w;
  }
  __syncthreads();
#pragma unroll
  for (int ci = 0; ci < 9; ++ci) red[(kg * 9 + ci) * 32 + col] = acc[ci];
  __syncthreads();
  float* mod = (float*)(p.ws + OFF_MOD) + layer * 9 * 3072;
  for (int idx = tid; idx < 288; idx += 256) {
    int ci = idx >> 5, cl = idx & 31;
    float s = 0.f;
    for (int k2 = 0; k2 < 8; ++k2) s += red[(k2 * 9 + ci) * 32 + cl];
    mod[ci * 3072 + nb * 32 + cl] = s + B[nb * 32 + cl];
  }
  __syncthreads();
}

ITEMFN void p0_fold(const Params& p, char* smem, int item) {
  const int tid = mytid();
  const int g = item >> 5, k0 = (item & 31) * 32;
  float* a = (float*)smem;
  float* ct = a + 32 * 128;
  float* st = ct + 128;
  const float* W = p.in[I_IN0W];
  for (int idx = tid; idx < 32 * 128; idx += 256) {
    int kk = idx >> 7, cc = idx & 127;
    a[idx] = W[(size_t)(k0 + kk) * 3072 + g * 128 + cc];
  }
  if (tid < 128) { float s, c; sincospif(2.f * (float)tid / 128.f, &s, &c); ct[tid] = c; st[tid] = s; }
  __syncthreads();
  const int q = tid & 127, kh = tid >> 7;
  const int k2 = q <= 64 ? q : q - 64;
  float acc[16];
#pragma unroll
  for (int kk = 0; kk < 16; ++kk) acc[kk] = 0.f;
#pragma unroll 1
  for (int cc = 0; cc < 128; ++cc) {
    int idx = (k2 * cc) & 127;
    float t = q <= 64 ? ct[idx] : -st[idx];
#pragma unroll
    for (int kk = 0; kk < 16; ++kk) acc[kk] += a[(kh * 16 + kk) * 128 + cc] * t;
  }
  bfr* dst = (bfr*)(p.ws + OFF_W0T) + (size_t)(g * 128 + q) * 1024 + k0 + kh * 16;
#pragma unroll
  for (int qq = 0; qq < 2; ++qq) {
    u32x4 v;
    v.x = pk2(acc[8 * qq + 0], acc[8 * qq + 1]); v.y = pk2(acc[8 * qq + 2], acc[8 * qq + 3]);
    v.z = pk2(acc[8 * qq + 4], acc[8 * qq + 5]); v.w = pk2(acc[8 * qq + 6], acc[8 * qq + 7]);
    *(u32x4*)(dst + 8 * qq) = v;
  }
  __syncthreads();
}

ITEMFN void p0_transpose(const Params& p, char* smem, int item) {
  const int tid = mytid();
  int nt = item >> 4;
  const int k0 = (item & 15) * 64;
  const float* src; int ld, coloff; bfr* dst;
  if (nt < 40) { src = p.in[I_IN0W]; ld = 3072; coloff = 512 + nt * 64; dst = (bfr*)(p.ws + OFF_W0T) + (size_t)(512 + nt * 64) * 1024; }
  else if (nt < 56) { nt -= 40; src = p.in[I_OUT0W]; ld = 1024; coloff = nt * 64; dst = (bfr*)(p.ws + OFF_WO0T) + (size_t)(nt * 64) * 1024; }
  else if (nt < 120) { nt -= 56; src = p.in[I_IN1W]; ld = 4096; coloff = nt * 64; dst = (bfr*)(p.ws + OFF_W1T) + (size_t)(nt * 64) * 1024; }
  else { nt -= 120; src = p.in[I_OUT1W]; ld = 1024; coloff = nt * 64; dst = (bfr*)(p.ws + OFF_WO1T) + (size_t)(nt * 64) * 1024; }
  float* t = (float*)smem;
#pragma unroll
  for (int i = 0; i < 4; ++i) {
    int idx = tid + 256 * i, kk = idx >> 4, c4 = idx & 15;
    f32x4 v = *(const f32x4*)(src + (size_t)(k0 + kk) * ld + coloff + 4 * c4);
    t[kk * 65 + 4 * c4 + 0] = v.x; t[kk * 65 + 4 * c4 + 1] = v.y; t[kk * 65 + 4 * c4 + 2] = v.z; t[kk * 65 + 4 * c4 + 3] = v.w;
  }
  __syncthreads();
#pragma unroll
  for (int i = 0; i < 2; ++i) {
    int idx = tid + 256 * i, nn = idx >> 3, kc = idx & 7;
    float f[8];
#pragma unroll
    for (int e = 0; e < 8; ++e) f[e] = t[(8 * kc + e) * 65 + nn];
    u32x4 v; v.x = pk2(f[0], f[1]); v.y = pk2(f[2], f[3]); v.z = pk2(f[4], f[5]); v.w = pk2(f[6], f[7]);
    *(u32x4*)(dst + (size_t)nn * 1024 + k0 + 8 * kc) = v;
  }
  __syncthreads();
}

ITEMFN void p0_cache(const Params& p, char* smem, int item) {
  const int tid = mytid();
  const int b = item >> 6, hd = (item >> 3) & 7, p0 = (item & 7) * 64;
  const float* ck = p.in[I_CK];
  const float* cv = p.in[I_CV];
  bfr* dk = (bfr*)(p.ws + OFF_CKB);
  bfr* dv = (bfr*)(p.ws + OFF_CVT);
  float* t = (float*)smem;
#pragma unroll
  for (int i = 0; i < 4; ++i) {
    int idx = tid + 256 * i, pp = idx >> 4, c4 = idx & 15;
    size_t so = ((size_t)(b * 512 + p0 + pp) * 8 + hd) * 64 + 4 * c4;
    f32x4 kv = *(const f32x4*)(ck + so);
    u32x2 o; o.x = pk2(kv.x, kv.y); o.y = pk2(kv.z, kv.w);
    *(u32x2*)(dk + ((size_t)(b * 8 + hd) * 512 + p0 + pp) * 64 + 4 * c4) = o;
    f32x4 v = *(const f32x4*)(cv + so);
    t[pp * 65 + 4 * c4 + 0] = v.x; t[pp * 65 + 4 * c4 + 1] = v.y; t[pp * 65 + 4 * c4 + 2] = v.z; t[pp * 65 + 4 * c4 + 3] = v.w;
  }
  __syncthreads();
#pragma unroll
  for (int i = 0; i < 2; ++i) {
    int idx = tid + 256 * i, dd = idx >> 3, pc = idx & 7;
    float f[8];
#pragma unroll
    for (int e = 0; e < 8; ++e) f[e] = t[(8 * pc + e) * 65 + dd];
    u32x4 v; v.x = pk2(f[0], f[1]); v.y = pk2(f[2], f[3]); v.z = pk2(f[4], f[5]); v.w = pk2(f[6], f[7]);
    *(u32x4*)(dv + ((size_t)(b * 8 + hd) * 64 + dd) * 512 + p0 + 8 * pc) = v;
  }
  __syncthreads();
}

ITEMFN void p0_hid(const Params& p, char* smem, int item) {
  const int tid = mytid();
  const int variant = item >= 16 ? 1 : 0;
  const int tb = variant ? item - 16 : item;
  const int L = variant ? 4096 : 256;
  float* w1s = (float*)smem;
  float* w2s = w1s + 2112;
  float* z = w2s + 4096;
  float* h1 = z + 144;
  for (int idx = tid; idx < 2112; idx += 256) w1s[idx] = p.in[I_FW1][idx];
  for (int idx = tid; idx < 4096; idx += 256) w2s[idx] = p.in[I_FW2][idx];
  const int tt = tid >> 6, j = tid & 63;
  const float b1 = p.in[I_FB1][j], f1 = p.in[I_FFR1][j], b2 = p.in[I_FB2][j], f2 = p.in[I_FFR2][j];
  float* hid = (float*)(p.ws + OFF_HID) + (variant ? 256 * 64 : 0);
  __syncthreads();
#pragma unroll 1
  for (int rd = 0; rd < 4; ++rd) {
    const int t = tb * 16 + rd * 4 + tt;
    if (j < 33) {
      float val;
      if (j == 0) val = (float)t / (float)(L - 1);
      else {
        int b = (j - 1) & 15;
        float f = 1e-4f + (float)b * ((15.0f - 1e-4f) / 15.0f);
        float w = (6.283185307179586f * (float)t) / (float)L;
        float a = f * w;
        val = j <= 16 ? cosf(a) : -sinf(a);
      }
      z[tt * 36 + j] = val;
    }
    __syncthreads();
    float pre = b1;
#pragma unroll
    for (int i = 0; i < 33; ++i) pre += z[tt * 36 + i] * w1s[i * 64 + j];
    h1[tt * 64 + j] = sinf(f1 * pre);
    __syncthreads();
    float pre2 = b2;
#pragma unroll 16
    for (int i = 0; i < 64; ++i) pre2 += h1[tt * 64 + i] * w2s[i * 64 + j];
    hid[(size_t)j * L + t] = sinf(f2 * pre2);
    __syncthreads();
  }
}

ITEMFN void norm_item(const Params& p, int item, int layer) {
  const int tid = mytid(), lane = tid & 63, wave = tid >> 6;
  const float* g = (layer ? p.in[I_NORM1G] : p.in[I_NORM0G]);
  const float* mod = (const float*)(p.ws + OFF_MOD) + layer * 9 * 3072;
  bfr* dst = (bfr*)(p.ws + (layer ? OFF_R2 : OFF_R1));
  for (int rr = 0; rr < 4; ++rr) {
    const int m = item * 16 + wave * 4 + rr;
    const float* xr = layer ? (const float*)p.out + (size_t)m * 1024
                            : (m < MP ? p.in[I_XP] + (size_t)m * 1024 : p.in[I_XS] + (size_t)(m - MP) * 1024);
    const int ci = m < MP ? 8 : (m - MP) >> 12;
    f32x4 v[4];
    float ss = 0.f;
#pragma unroll
    for (int i = 0; i < 4; ++i) {
      v[i] = *(const f32x4*)(xr + lane * 4 + 256 * i);
      ss += v[i].x * v[i].x + v[i].y * v[i].y + v[i].z * v[i].z + v[i].w * v[i].w;
    }
#pragma unroll
    for (int o = 32; o >= 1; o >>= 1) ss += __shfl_xor(ss, o);
    const float rs = rsqrtf(ss * (1.f / 1024.f) + 1e-6f);
#pragma unroll
    for (int i = 0; i < 4; ++i) {
      const int col = lane * 4 + 256 * i;
      f32x4 g4 = *(const f32x4*)(g + col);
      f32x4 sh = *(const f32x4*)(mod + ci * 3072 + col);
      f32x4 sc = *(const f32x4*)(mod + ci * 3072 + 1024 + col);
      float a = v[i].x * rs * g4.x * (1.f + sc.x) + sh.x;
      float b = v[i].y * rs * g4.y * (1.f + sc.y) + sh.y;
      float c = v[i].z * rs * g4.z * (1.f + sc.z) + sh.z;
      float d = v[i].w * rs * g4.w * (1.f + sc.w) + sh.w;
      u32x2 o; o.x = pk2(a, b); o.y = pk2(c, d);
      *(u32x2*)(dst + (size_t)m * 1024 + col) = o;
    }
  }
}

template <int NT>
DI void filt_body(const Params& p, float* wl, float* red, int tid, int variant, int order, int w0) {
  constexpr int L = NT * 256;
  const float* hid = (const float*)(p.ws + OFF_HID) + (variant ? 256 * 64 : 0);
  float* F = (float*)(p.ws + (variant ? OFF_F4096 : OFF_F256));
  float acc[NT][8];
#pragma unroll
  for (int i = 0; i < NT; ++i)
#pragma unroll
    for (int c8 = 0; c8 < 8; ++c8) acc[i][c8] = 0.f;
#pragma unroll 4
  for (int k = 0; k < 64; ++k) {
    float hv[NT];
#pragma unroll
    for (int i = 0; i < NT; ++i) hv[i] = hid[(size_t)k * L + tid + 256 * i];
    const f32x4 wa = *(const f32x4*)(wl + k * 8);
    const f32x4 wb = *(const f32x4*)(wl + k * 8 + 4);
#pragma unroll
    for (int i = 0; i < NT; ++i) {
      acc[i][0] += hv[i] * wa.x; acc[i][1] += hv[i] * wa.y; acc[i][2] += hv[i] * wa.z; acc[i][3] += hv[i] * wa.w;
      acc[i][4] += hv[i] * wb.x; acc[i][5] += hv[i] * wb.y; acc[i][6] += hv[i] * wb.z; acc[i][7] += hv[i] * wb.w;
    }
  }
  const float MIND = -3.0701134573253947f, MAXD = -15.350567286626973f;
  float asum[4] = {0.f, 0.f, 0.f, 0.f};
#pragma unroll
  for (int i = 0; i < NT; ++i) {
    const int t = tid + 256 * i;
    const float tn = (float)t / (float)(L - 1);
#pragma unroll
    for (int wi = 0; wi < 4; ++wi) {
      const float delta = fabsf(MIND + (float)(w0 + wi) * ((MAXD - MIND) / 1023.f));
      const float dec = expf(-tn * delta);
#pragma unroll
      for (int dir = 0; dir < 2; ++dir) {
        const float val = acc[i][dir * 4 + wi] * dec;
        asum[wi] += fabsf(val);
        F[((size_t)(dir * 2 + order) * 1024 + w0 + wi) * L + t] = val;
      }
    }
  }
#pragma unroll
  for (int wi = 0; wi < 4; ++wi) {
#pragma unroll
    for (int o = 32; o >= 1; o >>= 1) asum[wi] += __shfl_xor(asum[wi], o);
  }
  if ((tid & 63) == 0) {
#pragma unroll
    for (int wi = 0; wi < 4; ++wi) red[(tid >> 6) * 4 + wi] = asum[wi];
  }
}

ITEMFN void filt_item(const Params& p, char* smem, int item) {
  const int tid = mytid();
  const int variant = item >> 9, order = (item >> 8) & 1, w0 = (item & 255) * 4;
  float* wl = (float*)smem;
  float* red = wl + 512;
  const float* w3 = p.in[I_FW3];
  for (int idx = tid; idx < 512; idx += 256) {
    int k = idx >> 3, c8 = idx & 7, dir = c8 >> 2, wi = c8 & 3;
    wl[idx] = w3[(size_t)k * 4096 + dir * 2048 + order * 1024 + w0 + wi];
  }
  __syncthreads();
  if (variant) filt_body<16>(p, wl, red, tid, variant, order, w0);
  else filt_body<1>(p, wl, red, tid, variant, order, w0);
  __syncthreads();
  if (tid < 4) {
    float* fsum = (float*)(p.ws + OFF_FSUM);
    fsum[(variant * 2 + order) * 1024 + w0 + tid] = red[tid] + red[4 + tid] + red[8 + tid] + red[12 + tid];
  }
  __syncthreads();
}

DI int swz(int row, int chunk) { return row * 128 + (((chunk ^ (row >> 1) ^ (row >> 4)) & 7) << 4); }

template <bool AT>
DI void g_load(u32x4 (&rx)[4], u32x4 (&rw)[4], const bfr* __restrict__ X, const bfr* __restrict__ W, int m0, int n0, int k0) {
  const int tid = mytid();
#pragma unroll
  for (int i = 0; i < 4; ++i) {
    const int row = (tid >> 3) + 32 * i, c = tid & 7;
    rw[i] = *(const u32x4*)(W + (size_t)(n0 + row) * 1024 + k0 + 8 * c);
    if (!AT) rx[i] = *(const u32x4*)(X + (size_t)(m0 + row) * 1024 + k0 + 8 * c);
  }
  if (AT) {
#pragma unroll
    for (int i = 0; i < 2; ++i) {
      const int idx = tid + 256 * i, mc = idx & 15, kp = idx >> 4;
      rx[2 * i] = *(const u32x4*)(X + (size_t)(k0 + 2 * kp) * MT + m0 + 8 * mc);
      rx[2 * i + 1] = *(const u32x4*)(X + (size_t)(k0 + 2 * kp + 1) * MT + m0 + 8 * mc);
    }
  }
}
template <bool AT>
DI void g_store(const u32x4 (&rx)[4], const u32x4 (&rw)[4], char* Xs, char* Ws) {
  const int tid = mytid();
#pragma unroll
  for (int i = 0; i < 4; ++i) {
    const int row = (tid >> 3) + 32 * i, c = tid & 7;
    *(u32x4*)(Ws + swz(row, c)) = rw[i];
    if (!AT) *(u32x4*)(Xs + swz(row, c)) = rx[i];
  }
  if (AT) {
#pragma unroll
    for (int i = 0; i < 2; ++i) {
      const int idx = tid + 256 * i, mc = idx & 15, kp = idx >> 4;
      const unsigned lo[4] = {rx[2 * i].x, rx[2 * i].y, rx[2 * i].z, rx[2 * i].w};
      const unsigned hi[4] = {rx[2 * i + 1].x, rx[2 * i + 1].y, rx[2 * i + 1].z, rx[2 * i + 1].w};
#pragma unroll
      for (int e = 0; e < 8; ++e) {
        const unsigned a = lo[e >> 1], b = hi[e >> 1];
        const unsigned val = (e & 1) ? ((a >> 16) | (b & 0xffff0000u)) : ((a & 0xffffu) | (b << 16));
        const int row = 8 * mc + e;
        *(unsigned*)(Xs + swz(row, kp >> 2) + (kp & 3) * 4) = val;
      }
    }
  }
}

template <bool AT, bool SWAP>
DI void gemm_main(f32x16 (&acc)[2][2], const bfr* __restrict__ X, const bfr* __restrict__ W, int m0, int n0, char* smem) {
  char* Xs = smem;
  char* Ws = smem + 16384;
  const int tid = mytid(), lane = tid & 63, wave = tid >> 6, r = lane & 31, h = lane >> 5;
  const int wm = wave >> 1, wn = wave & 1;
#pragma unroll
  for (int a = 0; a < 2; ++a)
#pragma unroll
    for (int b = 0; b < 2; ++b)
#pragma unroll
      for (int i = 0; i < 16; ++i) acc[a][b][i] = 0.f;
  u32x4 rx[4], rw[4];
  g_load<AT>(rx, rw, X, W, m0, n0, 0);
  for (int kt = 0; kt < 16; ++kt) {
    __syncthreads();
    g_store<AT>(rx, rw, Xs, Ws);
    __syncthreads();
    if (kt < 15) g_load<AT>(rx, rw, X, W, m0, n0, (kt + 1) * 64);
#pragma unroll
    for (int s = 0; s < 4; ++s) {
      bf16x8 xf[2], wf[2];
#pragma unroll
      for (int t = 0; t < 2; ++t) {
        xf[t] = *(const bf16x8*)(Xs + swz(64 * wm + 32 * t + r, 2 * s + h));
        wf[t] = *(const bf16x8*)(Ws + swz(64 * wn + 32 * t + r, 2 * s + h));
      }
#pragma unroll
      for (int a = 0; a < 2; ++a)
#pragma unroll
        for (int b = 0; b < 2; ++b) {
          if (SWAP) acc[a][b] = MFMA(wf[a], xf[b], acc[a][b]);
          else acc[a][b] = MFMA(xf[a], wf[b], acc[a][b]);
        }
    }
  }
}

DI void gemm_main_big(f32x16 (&acc)[4][2], const bfr* __restrict__ X, const bfr* __restrict__ W, int m0, int n0, char* smem) {
  char* Xs = smem;
  char* Ws = smem + 16384;
  const int tid = mytid(), lane = tid & 63, wave = tid >> 6, r = lane & 31, h = lane >> 5;
  const int wm = wave >> 1, wn = wave & 1;
#pragma unroll
  for (int a = 0; a < 4; ++a)
#pragma unroll
    for (int b = 0; b < 2; ++b)
#pragma unroll
      for (int i = 0; i < 16; ++i) acc[a][b][i] = 0.f;
  u32x4 rx[4], rw[8];
  const int lrow = tid >> 3, lc = tid & 7;
  const bfr* xp = X + (size_t)(m0 + lrow) * 1024 + 8 * lc;
  const bfr* wp = W + (size_t)(n0 + lrow) * 1024 + 8 * lc;
#pragma unroll
  for (int i = 0; i < 4; ++i) rx[i] = *(const u32x4*)(xp + (size_t)(32 * i) * 1024);
#pragma unroll
  for (int i = 0; i < 8; ++i) rw[i] = *(const u32x4*)(wp + (size_t)(32 * i) * 1024);
  for (int kt = 0; kt < 16; ++kt) {
    __syncthreads();
#pragma unroll
    for (int i = 0; i < 4; ++i) *(u32x4*)(Xs + swz(lrow + 32 * i, lc)) = rx[i];
#pragma unroll
    for (int i = 0; i < 8; ++i) *(u32x4*)(Ws + swz(lrow + 32 * i, lc)) = rw[i];
    __syncthreads();
    if (kt < 15) {
#pragma unroll
      for (int i = 0; i < 4; ++i) rx[i] = *(const u32x4*)(xp + (size_t)(32 * i) * 1024 + (kt + 1) * 64);
#pragma unroll
      for (int i = 0; i < 8; ++i) rw[i] = *(const u32x4*)(wp + (size_t)(32 * i) * 1024 + (kt + 1) * 64);
    }
#pragma unroll
    for (int s = 0; s < 4; ++s) {
      bf16x8 xf[2], wf[4];
#pragma unroll
      for (int t = 0; t < 2; ++t) xf[t] = *(const bf16x8*)(Xs + swz(64 * wm + 32 * t + r, 2 * s + h));
#pragma unroll
      for (int t = 0; t < 4; ++t) wf[t] = *(const bf16x8*)(Ws + swz(128 * wn + 32 * t + r, 2 * s + h));
#pragma unroll
      for (int a = 0; a < 4; ++a)
#pragma unroll
        for (int b = 0; b < 2; ++b) acc[a][b] = MFMA(wf[a], xf[b], acc[a][b]);
    }
  }
}

template <bool SILU>
DI void store_T4(const f32x16 (&acc)[4][2], bfr* dst, int nrow0, int mcol0, int r, int h) {
#pragma unroll
  for (int tn = 0; tn < 4; ++tn)
#pragma unroll
    for (int tm = 0; tm < 2; ++tm)
#pragma unroll
      for (int i = 0; i < 16; ++i) {
        float v = acc[tn][tm][i];
        if (SILU) v = siluf(v);
        dst[(size_t)(nrow0 + 32 * tn + crow(i, h)) * MT + mcol0 + 32 * tm + r] = f2bf(v);
      }
}

template <bool SILU>
DI void store_T4_lds(const f32x16 (&acc)[4][2], bfr* dst, int nrow0, int mcol0, char* smem, int wave, int lane) {
  const int r = lane & 31, h = lane >> 5;
  char* reg = smem + wave * 9216;
  __syncthreads();
#pragma unroll
  for (int half = 0; half < 2; ++half) {
#pragma unroll
    for (int t2 = 0; t2 < 2; ++t2)
#pragma unroll
      for (int tm = 0; tm < 2; ++tm)
#pragma unroll
        for (int i = 0; i < 16; ++i) {
          float v = acc[2 * half + t2][tm][i];
          if (SILU) v = siluf(v);
          *(bfr*)(reg + (32 * t2 + crow(i, h)) * 144 + (32 * tm + r) * 2) = f2bf(v);
        }
    __syncthreads();
#pragma unroll
    for (int q = 0; q < 8; ++q) {
      const int idx = lane + 64 * q, row = idx >> 3, ch = idx & 7;
      const u32x4 v = *(const u32x4*)(reg + row * 144 + ch * 16);
      __builtin_nontemporal_store(v, (u32x4*)(dst + (size_t)(nrow0 + 64 * half + row) * MT + mcol0 + 8 * ch));
    }
    __syncthreads();
  }
}

template <bool SILU>
DI void store_T(const f32x16 (&acc)[2][2], bfr* dst, int nrow0, int mcol0, int r, int h) {
#pragma unroll
  for (int tn = 0; tn < 2; ++tn)
#pragma unroll
    for (int tm = 0; tm < 2; ++tm)
#pragma unroll
      for (int i = 0; i < 16; ++i) {
        float v = acc[tn][tm][i];
        if (SILU) v = siluf(v);
        dst[(size_t)(nrow0 + 32 * tn + crow(i, h)) * MT + mcol0 + 32 * tm + r] = f2bf(v);
      }
}

template <int NT, int GN>
DI void tile_map(int lt, int x, int& mt, int& nt) {
  const int grp = lt / (8 * GN), in = lt % (8 * GN);
  const int lmh = grp / (NT / GN), nth = grp % (NT / GN);
  mt = (lmh * 8 + in / GN) * 8 + x;
  nt = nth * GN + in % GN;
}

ITEMFN void inproj0_tile(const Params& p, char* smem, int mt, int nt) {
  const int m0 = mt * 128, n0 = nt * 256;
  f32x16 acc[4][2];
  gemm_main_big(acc, (const bfr*)(p.ws + OFF_R1), (const bfr*)(p.ws + OFF_W0T), m0, n0, smem);
  const int tid = mytid(), lane = tid & 63, wave = tid >> 6, r = lane & 31, h = lane >> 5;
  const int mb = m0 + 64 * (wave >> 1), nb = n0 + 128 * (wave & 1);
  if (n0 < 512) { store_T4_lds<false>(acc, (bfr*)(p.ws + OFF_R2), nb, mb, smem, wave, lane); return; }
  const int region = (n0 - 512) >> 9;
  const int nl = nb - 512 - region * 512;
  if (region == 0) { store_T4_lds<true>(acc, (bfr*)(p.ws + OFF_AGT), nl, mb, smem, wave, lane); return; }
  if (region == 4) { store_T4_lds<true>(acc, (bfr*)(p.ws + OFF_BGT), nl, mb, smem, wave, lane); return; }
  if (region == 3) {
    store_T4_lds<false>(acc, (bfr*)(p.ws + OFF_VT), nl, mb, smem, wave, lane);
    if (m0 < MP) {
      float* ov = p.out + OUT_V;
#pragma unroll
      for (int tn = 0; tn < 4; ++tn)
#pragma unroll
        for (int tm = 0; tm < 2; ++tm)
#pragma unroll
          for (int g4 = 0; g4 < 4; ++g4) {
            f32x4 o; o.x = acc[tn][tm][4 * g4]; o.y = acc[tn][tm][4 * g4 + 1]; o.z = acc[tn][tm][4 * g4 + 2]; o.w = acc[tn][tm][4 * g4 + 3];
            *(f32x4*)(ov + (size_t)(mb + 32 * tm + r) * 512 + nl + 32 * tn + 8 * g4 + 4 * h) = o;
          }
    }
    return;
  }
  const float* gg = (region == 1 ? p.in[I_QNG] : p.in[I_KNG]);
  const float qs = region == 1 ? 0.125f * 1.4426950408889634f : 1.f;
  bfr* dst = (bfr*)(p.ws + (region == 1 ? OFF_Q : OFF_K));
#pragma unroll
  for (int tm = 0; tm < 2; ++tm) {
    const int m = mb + 32 * tm + r;
#pragma unroll
    for (int hh = 0; hh < 2; ++hh) {
      float ss = 0.f;
#pragma unroll
      for (int t2 = 0; t2 < 2; ++t2)
#pragma unroll
        for (int i = 0; i < 16; ++i) ss += acc[2 * hh + t2][tm][i] * acc[2 * hh + t2][tm][i];
      ss += __shfl_xor(ss, 32);
      const float rs = rsqrtf(ss * (1.f / 64.f) + 1e-6f);
#pragma unroll
      for (int t2 = 0; t2 < 2; ++t2)
#pragma unroll
        for (int g4 = 0; g4 < 4; ++g4) {
          const int d0 = 32 * t2 + 8 * g4 + 4 * h;
          f32x4 gv = *(const f32x4*)(gg + d0);
          f32x4 o;
          o.x = acc[2 * hh + t2][tm][4 * g4] * rs * gv.x; o.y = acc[2 * hh + t2][tm][4 * g4 + 1] * rs * gv.y;
          o.z = acc[2 * hh + t2][tm][4 * g4 + 2] * rs * gv.z; o.w = acc[2 * hh + t2][tm][4 * g4 + 3] * rs * gv.w;
          const int col = nl + 64 * hh + d0;
          if (region == 2 && m0 < MP) *(f32x4*)(p.out + OUT_K + (size_t)m * 512 + col) = o;
          u32x2 ob; ob.x = pk2(o.x * qs, o.y * qs); ob.y = pk2(o.z * qs, o.w * qs);
          *(u32x2*)(dst + (size_t)m * 512 + col) = ob;
        }
    }
  }
}

ITEMFN void inproj1_tile(const Params& p, char* smem, int mt, int nt) {
  const int m0 = mt * 128, n0 = nt * 256;
  f32x16 acc[4][2];
  gemm_main_big(acc, (const bfr*)(p.ws + OFF_R2), (const bfr*)(p.ws + OFF_W1T), m0, n0, smem);
  const int tid = mytid(), lane = tid & 63, wave = tid >> 6, r = lane & 31, h = lane >> 5;
  store_T4_lds<false>(acc, (bfr*)(p.ws + OFF_BIG), n0 + 128 * (wave & 1), m0 + 64 * (wave >> 1), smem, wave, lane);
}

ITEMFN void outproj_tile(const Params& p, char* smem, int mt, int nt, int layer) {
  const int m0 = mt * 128, n0 = nt * 128;
  f32x16 acc[2][2];
  gemm_main<false, false>(acc, (const bfr*)(p.ws + (layer ? OFF_BIG : OFF_R2)), (const bfr*)(p.ws + (layer ? OFF_WO1T : OFF_WO0T)), m0, n0, smem);
  const int tid = mytid(), lane = tid & 63, wave = tid >> 6, r = lane & 31, h = lane >> 5;
  const int mb = m0 + 64 * (wave >> 1), nb = n0 + 64 * (wave & 1);
  const float* mod = (const float*)(p.ws + OFF_MOD) + layer * 9 * 3072;
  const int ci = m0 < MP ? 8 : (m0 - MP) >> 12;
#pragma unroll
  for (int tm = 0; tm < 2; ++tm)
#pragma unroll
    for (int tn = 0; tn < 2; ++tn) {
      const int n = nb + 32 * tn + r;
      const float gate = mod[ci * 3072 + 2048 + n];
#pragma unroll
      for (int i = 0; i < 16; ++i) {
        const int m = mb + 32 * tm + crow(i, h);
        float xin;
        if (layer) xin = __builtin_nontemporal_load(p.out + (size_t)m * 1024 + n);
        else xin = m < MP ? __builtin_nontemporal_load(p.in[I_XP] + (size_t)m * 1024 + n) : __builtin_nontemporal_load(p.in[I_XS] + (size_t)(m - MP) * 1024 + n);
        const float res = xin + gate * acc[tm][tn][i];
        if (layer) __builtin_nontemporal_store(res, p.out + (size_t)m * 1024 + n);
        else p.out[(size_t)m * 1024 + n] = res;
      }
    }
}

ITEMFN void xpose_item(const Params& p, char* smem, int item, int layer) {
  const int tid = mytid();
  const bfr* src = (const bfr*)(p.ws + (layer ? OFF_R2 : OFF_R1));
  bfr* dst = (bfr*)(p.ws + (layer ? OFF_BIG : OFF_R2));
  const int k0 = (item & 15) * 64, m0 = (item >> 4) * 64;
  unsigned* t = (unsigned*)smem;
  {
    const int mc = tid & 7, kp = tid >> 3;
    const u32x4 a = *(const u32x4*)(src + (size_t)(k0 + 2 * kp) * MT + m0 + 8 * mc);
    const u32x4 b = *(const u32x4*)(src + (size_t)(k0 + 2 * kp + 1) * MT + m0 + 8 * mc);
    const unsigned lo[4] = {a.x, a.y, a.z, a.w};
    const unsigned hi[4] = {b.x, b.y, b.z, b.w};
#pragma unroll
    for (int e = 0; e < 8; ++e) {
      const unsigned x = lo[e >> 1], y = hi[e >> 1];
      const unsigned val = (e & 1) ? ((x >> 16) | (y & 0xffff0000u)) : ((x & 0xffffu) | (y << 16));
      t[(8 * mc + e) * 33 + kp] = val;
    }
  }
  __syncthreads();
#pragma unroll
  for (int i = 0; i < 2; ++i) {
    const int idx = tid + 256 * i, c = idx & 7, m = idx >> 3;
    u32x4 v;
    v.x = t[m * 33 + 4 * c + 0]; v.y = t[m * 33 + 4 * c + 1]; v.z = t[m * 33 + 4 * c + 2]; v.w = t[m * 33 + 4 * c + 3];
    *(u32x4*)(dst + (size_t)(m0 + m) * 1024 + k0 + 8 * c) = v;
  }
  __syncthreads();
}

struct AttnState { f32x16 o[2]; float mrun, lrun; };

DI void kv_gload(u32x4 (&kr)[2], u32x4 (&vr)[2], const bfr* kptr, size_t kstride, const bfr* vptr, size_t vstride, int tid) {
#pragma unroll
  for (int i = 0; i < 2; ++i) {
    const int idx = tid + 256 * i, row = idx >> 3, c = idx & 7;
    kr[i] = *(const u32x4*)(kptr + (size_t)row * kstride + 8 * c);
    vr[i] = *(const u32x4*)(vptr + (size_t)row * vstride + 8 * c);
  }
}
DI void kv_lstore(const u32x4 (&kr)[2], const u32x4 (&vr)[2], char* Ks, char* Vs, int tid) {
#pragma unroll
  for (int i = 0; i < 2; ++i) {
    const int idx = tid + 256 * i, row = idx >> 3, c = idx & 7;
    *(u32x4*)(Ks + row * 144 + c * 16) = kr[i];
    *(u32x4*)(Vs + row * 144 + c * 16) = vr[i];
  }
}

template <bool LOCAL>
DI void attn_chunk(AttnState& st, const bf16x8 (&qf)[4], const char* Ks, const char* Vs, int r, int h,
                   const float* brow, int qc, int cs) {
#pragma unroll
  for (int kt = 0; kt < 2; ++kt) {
    f32x16 s;
#pragma unroll
    for (int i = 0; i < 16; ++i) s[i] = 0.f;
#pragma unroll
    for (int sd = 0; sd < 4; ++sd) {
      bf16x8 kf = *(const bf16x8*)(Ks + (kt * 32 + r) * 144 + (16 * sd + 8 * h) * 2);
      s = MFMA(kf, qf[sd], s);
    }
    if (LOCAL) {
#pragma unroll
      for (int i = 0; i < 16; ++i) {
        const int kc = kt * 32 + crow(i, h);
        const bool valid = (kc >= cs) && (kc < cs + 16);
        const int bi = clampi(kc - qc + 15, 0, 30);
        s[i] = valid ? s[i] + brow[bi] : -INFINITY;
      }
    }
    float mx = s[0];
#pragma unroll
    for (int i = 1; i < 16; ++i) mx = fmaxf(mx, s[i]);
    {
      const unsigned mu = __float_as_uint(mx);
      const auto sw = __builtin_amdgcn_permlane32_swap(mu, mu, false, false);
      mx = fmaxf(__uint_as_float(sw[0]), __uint_as_float(sw[1]));
    }
    if (__builtin_amdgcn_ballot_w64(mx - st.mrun > 8.0f) != 0ull) {
      const float mnew = fmaxf(st.mrun, mx);
      const float alpha = __builtin_amdgcn_exp2f(st.mrun - mnew);
      st.lrun *= alpha;
#pragma unroll
      for (int td = 0; td < 2; ++td)
#pragma unroll
        for (int i = 0; i < 16; ++i) st.o[td][i] *= alpha;
      st.mrun = mnew;
    }
    float ps = 0.f;
#pragma unroll
    for (int i = 0; i < 16; ++i) { s[i] = __builtin_amdgcn_exp2f(s[i] - st.mrun); ps += s[i]; }
    st.lrun += ps;
#pragma unroll
    for (int sp = 0; sp < 2; ++sp) {
      bf16x8 pf;
#pragma unroll
      for (int j = 0; j < 8; ++j) pf[j] = (short)f2bf(s[8 * sp + j]);
#pragma unroll
      for (int td = 0; td < 2; ++td) {
        const char* vp = Vs + (32 * td + r) * 144 + (kt * 32 + 16 * sp + 4 * h) * 2;
        s16x4 lo = *(const s16x4*)vp;
        s16x4 hi = *(const s16x4*)(vp + 16);
        bf16x8 vf;
        vf[0] = lo[0]; vf[1] = lo[1]; vf[2] = lo[2]; vf[3] = lo[3];
        vf[4] = hi[0]; vf[5] = hi[1]; vf[6] = hi[2]; vf[7] = hi[3];
        st.o[td] = MFMA(vf, pf, st.o[td]);
      }
    }
  }
}

DI void attn_finish(const Params& p, AttnState& st, int hd, size_t m, int h) {
  const float l = st.lrun + __shfl_xor(st.lrun, 32);
  const float inv = 1.f / l;
  const bfr* bg = (const bfr*)(p.ws + OFF_BGT);
  bfr* dst = (bfr*)(p.ws + OFF_R1);
#pragma unroll
  for (int td = 0; td < 2; ++td)
#pragma unroll
    for (int i = 0; i < 16; ++i) {
      const int d = 32 * td + crow(i, h);
      const float g = bf2f(bg[(size_t)(hd * 64 + d) * MT + m]);
      dst[(size_t)(512 + hd * 64 + d) * MT + m] = f2bf(st.o[td][i] * inv * g);
    }
}

DI void attn_init(AttnState& st) {
#pragma unroll
  for (int td = 0; td < 2; ++td)
#pragma unroll
    for (int i = 0; i < 16; ++i) st.o[td][i] = 0.f;
  st.mrun = -INFINITY;
  st.lrun = 0.f;
}

ITEMFN void attn_na_item(const Params& p, char* smem, int item) {
  const int tid = mytid(), lane = tid & 63, wave = tid >> 6, r = lane & 31, h = lane >> 5;
  const int b = item >> 8, hd = (item >> 5) & 7, rp = item & 31;
  float* bias = (float*)(smem + 36864);
  const size_t mbase = MP + (size_t)b * 4096;
  const int r0 = 2 * rp, qr = r0 + (wave >> 1), c0 = 32 * (wave & 1);
  const int kr0 = clampi(r0 - 4, 0, 56), kr_end = clampi(r0 - 3, 0, 56) + 8;
  const int rsw = clampi(qr - 4, 0, 56);
  const int nch = 8 + (kr_end - kr0);
  __syncthreads();
  for (int idx = tid; idx < 465; idx += 256) bias[idx] = p.in[I_RELB][hd * 465 + idx] * 1.4426950408889634f;
  const size_t mq = mbase + qr * 64 + c0 + r;
  const bfr* qp = (const bfr*)(p.ws + OFF_Q) + mq * 512 + hd * 64;
  bf16x8 qf[4];
#pragma unroll
  for (int sd = 0; sd < 4; ++sd) qf[sd] = *(const bf16x8*)(qp + 16 * sd + 8 * h);
  AttnState st;
  attn_init(st);
  const bfr* ckb = (const bfr*)(p.ws + OFF_CKB) + (size_t)(b * 8 + hd) * 512 * 64;
  const bfr* cvt = (const bfr*)(p.ws + OFF_CVT) + (size_t)(b * 8 + hd) * 64 * 512;
  const bfr* kb = (const bfr*)(p.ws + OFF_K) + mbase * 512 + hd * 64;
  const bfr* vt = (const bfr*)(p.ws + OFF_VT) + (size_t)(hd * 64) * MT + mbase;
  const int qc = c0 + r, cs = clampi(qc - 8, 0, 48);
  u32x4 kreg[2], vreg[2];
  kv_gload(kreg, vreg, ckb, 64, cvt, 512, tid);
  kv_lstore(kreg, vreg, smem, smem + 9216, tid);
  __syncthreads();
#pragma unroll 1
  for (int c = 0; c < nch; ++c) {
    char* Ks = smem + (c & 1) * 18432;
    char* Vs = Ks + 9216;
    if (c + 1 < nch) {
      const int cn = c + 1;
      if (cn < 8) kv_gload(kreg, vreg, ckb + (size_t)cn * 64 * 64, 64, cvt + cn * 64, 512, tid);
      else { const int kr = kr0 + cn - 8; kv_gload(kreg, vreg, kb + (size_t)kr * 64 * 512, 512, vt + kr * 64, MT, tid); }
    }
    if (c < 8) attn_chunk<false>(st, qf, Ks, Vs, r, h, nullptr, 0, 0);
    else {
      const int kr = kr0 + c - 8;
      if (kr >= rsw && kr < rsw + 8) attn_chunk<true>(st, qf, Ks, Vs, r, h, bias + (kr - qr + 7) * 31, qc, cs);
    }
    if (c + 1 < nch) kv_lstore(kreg, vreg, smem + ((c + 1) & 1) * 18432, smem + ((c + 1) & 1) * 18432 + 9216, tid);
    __syncthreads();
  }
  attn_finish(p, st, hd, mq, h);
}

ITEMFN void attn_ctx_item(const Params& p, char* smem, int item) {
  const int tid = mytid(), lane = tid & 63, wave = tid >> 6, r = lane & 31, h = lane >> 5;
  const int b = item >> 4, hd = (item >> 1) & 7, qh = item & 1;
  const size_t mbase = (size_t)b * 256;
  const size_t mq = mbase + qh * 128 + wave * 32 + r;
  const bfr* qp = (const bfr*)(p.ws + OFF_Q) + mq * 512 + hd * 64;
  bf16x8 qf[4];
#pragma unroll
  for (int sd = 0; sd < 4; ++sd) qf[sd] = *(const bf16x8*)(qp + 16 * sd + 8 * h);
  AttnState st;
  attn_init(st);
  const bfr* kb = (const bfr*)(p.ws + OFF_K) + mbase * 512 + hd * 64;
  const bfr* vt = (const bfr*)(p.ws + OFF_VT) + (size_t)(hd * 64) * MT + mbase;
  u32x4 kreg[2], vreg[2];
  __syncthreads();
  kv_gload(kreg, vreg, kb, 512, vt, MT, tid);
  kv_lstore(kreg, vreg, smem, smem + 9216, tid);
  __syncthreads();
#pragma unroll 1
  for (int c = 0; c < 4; ++c) {
    char* Ks = smem + (c & 1) * 18432;
    char* Vs = Ks + 9216;
    if (c + 1 < 4) kv_gload(kreg, vreg, kb + (size_t)(c + 1) * 64 * 512, 512, vt + (c + 1) * 64, MT, tid);
    attn_chunk<false>(st, qf, Ks, Vs, r, h, nullptr, 0, 0);
    if (c + 1 < 4) kv_lstore(kreg, vreg, smem + ((c + 1) & 1) * 18432, smem + ((c + 1) & 1) * 18432 + 9216, tid);
    __syncthreads();
  }
  attn_finish(p, st, hd, mq, h);
}

DI void fft_fwd(cpx (&v)[16], cpx* buf, int tid) {
  __syncthreads();
  fft_fwd_pass<256, false, true>(v, buf, tid);
  __syncthreads();
  fft_fwd_pass<16, true, true>(v, buf, tid);
  __syncthreads();
  fft_fwd_pass<1, true, false>(v, buf, tid);
}
DI void fft_inv(cpx (&v)[16], cpx* buf, int tid) {
  __syncthreads();
  fft_inv_pass<1, false, true>(v, buf, tid);
  __syncthreads();
  fft_inv_pass<16, true, true>(v, buf, tid);
  __syncthreads();
  fft_inv_pass<256, true, false>(v, buf, tid);
}

DI void fft_fwd_lds(cpx (&v)[16], cpx* buf, int tid) {
  fft_fwd_pass<256, true, true>(v, buf, tid);
  __syncthreads();
  fft_fwd_pass<16, true, true>(v, buf, tid);
  __syncthreads();
  fft_fwd_pass<1, true, false>(v, buf, tid);
}
DI void fft_inv_lds(cpx (&v)[16], cpx* buf, int tid) {
  __syncthreads();
  fft_inv_pass<1, false, true>(v, buf, tid);
  __syncthreads();
  fft_inv_pass<16, true, true>(v, buf, tid);
  __syncthreads();
  fft_inv_pass<256, true, true>(v, buf, tid);
}

ITEMFN void fnet_item(const Params& p, char* smem, int item, bool prompt) {
  const int tid = mytid();
  cpx* buf = (cpx*)smem;
  float* rb = (float*)smem;
  const int sb = item / 260, rem = item - sb * 260, g = rem / 65, k2 = rem - g * 65;
  const size_t mbase = prompt ? (size_t)sb * 4096 : MP + (size_t)sb * 4096;
  const bool has_im = (k2 != 0) && (k2 != 64);
  const bfr* re = (const bfr*)(p.ws + OFF_R2) + (size_t)(g * 128 + k2) * MT + mbase;
  const bfr* im = (const bfr*)(p.ws + OFF_R2) + (size_t)(g * 128 + 64 + (has_im ? k2 : 1)) * MT + mbase;
  cpx v[16];
  float scale;
  if (!prompt) {
#pragma unroll
    for (int jj = 0; jj < 16; ++jj) { v[jj].x = bf2f(re[tid + 256 * jj]); v[jj].y = has_im ? bf2f(im[tid + 256 * jj]) : 0.f; }
    fft_fwd(v, buf, tid);
    __syncthreads();
    scale = 0.0013810679320049757f;
#pragma unroll
    for (int k = 0; k < 16; ++k) { const int idx = k * 256 + (tid & 15) * 16 + (tid >> 4); rb[idx + (idx >> 4)] = v[k].x * scale; }
  } else {
    const int base = (tid >> 4) * 256 + (tid & 15);
#pragma unroll
    for (int jj = 0; jj < 16; ++jj) { v[jj].x = bf2f(re[base + 16 * jj]); v[jj].y = has_im ? bf2f(im[base + 16 * jj]) : 0.f; }
    __syncthreads();
    fft_fwd_pass<16, false, true>(v, buf, tid);
    __syncthreads();
    fft_fwd_pass<1, true, false>(v, buf, tid);
    __syncthreads();
    scale = 0.005524271728019903f;
#pragma unroll
    for (int k = 0; k < 16; ++k) { const int idx = (tid >> 4) * 256 + k * 16 + (tid & 15); rb[idx + (idx >> 4)] = v[k].x * scale; }
  }
  __syncthreads();
  const int lmask = prompt ? 255 : 4095;
  {
    const int j1 = g * 128 + k2;
    const bfr* ag = (const bfr*)(p.ws + OFF_AGT) + (size_t)j1 * MT + mbase;
    bfr* dst = (bfr*)(p.ws + OFF_R1) + (size_t)j1 * MT + mbase;
#pragma unroll
    for (int i = 0; i < 2; ++i) {
      const int q0 = 8 * (tid + 256 * i);
      u32x4 a = *(const u32x4*)(ag + q0);
      const unsigned au[4] = {a.x, a.y, a.z, a.w};
      float f[8];
#pragma unroll
      for (int e = 0; e < 8; ++e) {
        const float gv = (e & 1) ? __uint_as_float(au[e >> 1] & 0xffff0000u) : __uint_as_float(au[e >> 1] << 16);
        f[e] = rb[q0 + (q0 >> 4) + e] * gv;
      }
      u32x4 o; o.x = pk2(f[0], f[1]); o.y = pk2(f[2], f[3]); o.z = pk2(f[4], f[5]); o.w = pk2(f[6], f[7]);
      *(u32x4*)(dst + q0) = o;
    }
  }
  if (has_im) {
    const int j2 = g * 128 + 128 - k2;
    const bfr* ag = (const bfr*)(p.ws + OFF_AGT) + (size_t)j2 * MT + mbase;
    bfr* dst = (bfr*)(p.ws + OFF_R1) + (size_t)j2 * MT + mbase;
#pragma unroll
    for (int i = 0; i < 2; ++i) {
      const int q0 = 8 * (tid + 256 * i);
      u32x4 a = *(const u32x4*)(ag + q0);
      const unsigned au[4] = {a.x, a.y, a.z, a.w};
      float f[8];
#pragma unroll
      for (int e = 0; e < 8; ++e) {
        const float gv = (e & 1) ? __uint_as_float(au[e >> 1] & 0xffff0000u) : __uint_as_float(au[e >> 1] << 16);
        const int k1 = q0 + e;
        const int src = (k1 & ~lmask) | ((lmask + 1 - (k1 & lmask)) & lmask);
        f[e] = rb[src + (src >> 4)] * gv;
      }
      u32x4 o; o.x = pk2(f[0], f[1]); o.y = pk2(f[2], f[3]); o.z = pk2(f[4], f[5]); o.w = pk2(f[6], f[7]);
      *(u32x4*)(dst + q0) = o;
    }
  }
  __syncthreads();
}

DI float conv3(const bfr* row, int n, int L, float w0, float w1, float w2, float bias) {
  const float a = n > 0 ? bf2f(row[n - 1]) : 0.f;
  const float b = bf2f(row[n]);
  const float c = n < L - 1 ? bf2f(row[n + 1]) : 0.f;
  return a * w0 + b * w1 + c * w2 + bias;
}

DI void stage_rows(bfr* l0, bfr* l1, const bfr* g0, const bfr* g1, int tid) {
#pragma unroll
  for (int i = 0; i < 2; ++i) {
    const int ch = tid + 256 * i;
    const u32x4 a = *(const u32x4*)(g0 + 8 * ch);
    const u32x4 b = *(const u32x4*)(g1 + 8 * ch);
    *(u32x4*)(l0 + 8 * ch) = a;
    *(u32x4*)(l1 + 8 * ch) = b;
  }
}
DI float conv3l(const bfr* row, int n, float w0, float w1, float w2, float bias) {
  const float a = bf2f(row[n > 0 ? n - 1 : 0]);
  const float b = bf2f(row[n]);
  const float c = bf2f(row[n < 4095 ? n + 1 : 4095]);
  return (n > 0 ? a : 0.f) * w0 + b * w1 + (n < 4095 ? c : 0.f) * w2 + bias;
}

ITEMFN void hyena_sample_item(const Params& p, char* smem, int c) {
  const int tid = mytid();
  cpx* buf = (cpx*)smem;
  bfr* raw0 = (bfr*)smem;
  bfr* raw1 = (bfr*)(smem + 8192);
  bfr* raw2 = (bfr*)(smem + 16384);
  bfr* raw3 = (bfr*)(smem + 24576);
  const float* scw = p.in[I_SCW];
  const float* scb = p.in[I_SCB];
  bfr* proj = (bfr*)(p.ws + OFF_BIG);
  bfr* P0 = proj + (size_t)c * MT + MP;
  bfr* P1 = proj + (size_t)(1024 + c) * MT + MP;
  const bfr* P2 = proj + (size_t)(2048 + c) * MT + MP;
  const bfr* PG = proj + (size_t)(3072 + c) * MT + MP;
  bfr* dst = (bfr*)(p.ws + OFF_R2) + (size_t)c * MT + MP;
  const float* fsum = (const float*)(p.ws + OFF_FSUM) + 2 * 1024;
  const float* F = (const float*)(p.ws + OFF_F4096);
#pragma unroll 1
  for (int order = 0; order < 2; ++order) {
    const float* hf = F + ((size_t)(0 * 2 + order) * 1024 + c) * 4096;
    const float* hb = F + ((size_t)(1 * 2 + order) * 1024 + c) * 4096;
    const float skip = p.in[I_FSKIP][order * 1024 + c];
    const int col1 = (order + 1) * 1024 + c;
    const float a0 = scw[c], a1 = scw[3072 + c], a2 = scw[6144 + c], ab = scb[c];
    const float m0 = scw[col1], m1 = scw[3072 + col1], m2 = scw[6144 + col1], mb = scb[col1];
    const bfr* PM = order == 0 ? P1 : P2;
    unsigned* ysc = order == 0 ? (unsigned*)dst : (unsigned*)P1;
    cpx G[16];
    {
    const float inv = 1.f / (fsum[order * 1024 + c] + 1e-6f);
    int tt = tid; OPAQUE(tt);
#pragma unroll
    for (int j = 0; j < 16; ++j) {
      const unsigned n = (unsigned)tt + 256u * j;
      const float a = hf[n] * inv + (n == 0u ? skip : 0.f);
      const float bq = n >= 1u ? hb[4096u - n] * inv : 0.f;
      G[j].x = a + bq; G[j].y = 0.f;
    }
    }
    fft_fwd(G, buf, tid);
#pragma unroll 1
    for (int pp = 0; pp < 4; ++pp) {
      int tq = tid; OPAQUE(tq);
      const bfr* r0 = P0 + (size_t)(2 * pp) * 4096;
      const bfr* r1 = P0 + (size_t)(2 * pp + 1) * 4096;
      cpx w[16];
      __syncthreads();
      stage_rows(raw0, raw1, r0, r1, tq);
      __syncthreads();
#pragma unroll
      for (int j = 0; j < 16; ++j) {
        const int n = tq + 256 * j;
        if (order == 0) { w[j].x = conv3l(raw0, n, a0, a1, a2, ab); w[j].y = conv3l(raw1, n, a0, a1, a2, ab); }
        else { w[j].x = bf2f(raw0[n]); w[j].y = bf2f(raw1[n]); }
      }
      fft_fwd(w, buf, tq);
#pragma unroll
      for (int k = 0; k < 16; ++k) w[k] = cmul(w[k], G[k]);
      fft_inv(w, buf, tq);
#pragma unroll
      for (int j = 0; j < 16; ++j) ysc[pp * 4096 + tq + 256 * j] = pk2(w[j].x * (1.f / 8192.f), w[j].y * (1.f / 8192.f));
    }
    {
    const float inv = 1.f / (fsum[order * 1024 + c] + 1e-6f);
    int tt = tid; OPAQUE(tt);
#pragma unroll
    for (int j = 0; j < 16; ++j) {
      const unsigned n = (unsigned)tt + 256u * j;
      const float a = hf[n] * inv + (n == 0u ? skip : 0.f);
      const float bq = n >= 1u ? hb[4096u - n] * inv : 0.f;
      float s, cs;
      SINCOSPI((float)n * (1.f / 4096.f), &s, &cs);
      const float d = a - bq;
      G[j].x = d * cs; G[j].y = -d * s;
    }
    }
    fft_fwd(G, buf, tid);
#pragma unroll 1
    for (int pp = 0; pp < 4; ++pp) {
      int tq = tid; OPAQUE(tq);
      bfr* r0 = P0 + (size_t)(2 * pp) * 4096;
      bfr* r1 = P0 + (size_t)(2 * pp + 1) * 4096;
      cpx w[16];
      __syncthreads();
      stage_rows(raw0, raw1, r0, r1, tq);
      __syncthreads();
#pragma unroll
      for (int j = 0; j < 16; ++j) {
        const int n = tq + 256 * j;
        cpx z;
        if (order == 0) { z.x = conv3l(raw0, n, a0, a1, a2, ab); z.y = conv3l(raw1, n, a0, a1, a2, ab); }
        else { z.x = bf2f(raw0[n]); z.y = bf2f(raw1[n]); }
        float s, cs;
        { int no = n; OPAQUE(no); SINCOSPI((float)no * (1.f / 4096.f), &s, &cs); }
        cpx tw; tw.x = cs; tw.y = -s;
        w[j] = cmul(z, tw);
      }
      fft_fwd(w, buf, tq);
#pragma unroll
      for (int k = 0; k < 16; ++k) w[k] = cmul(w[k], G[k]);
      fft_inv(w, buf, tq);
      unsigned ye[16];
#pragma unroll
      for (int j = 0; j < 16; ++j) ye[j] = ysc[pp * 4096 + tq + 256 * j];
      __syncthreads();
      stage_rows(raw0, raw1, PM + (size_t)(2 * pp) * 4096, PM + (size_t)(2 * pp + 1) * 4096, tq);
      if (order == 1) stage_rows(raw2, raw3, PG + (size_t)(2 * pp) * 4096, PG + (size_t)(2 * pp + 1) * 4096, tq);
      __syncthreads();
      bfr* o0 = order == 0 ? r0 : dst + (size_t)(2 * pp) * 4096;
      bfr* o1 = order == 0 ? r1 : dst + (size_t)(2 * pp + 1) * 4096;
#pragma unroll
      for (int j = 0; j < 16; ++j) {
        const int n = tq + 256 * j;
        float s, cs;
        { int no = n; OPAQUE(no); SINCOSPI((float)no * (1.f / 4096.f), &s, &cs); }
        cpx tw; tw.x = cs; tw.y = -s;
        const cpx yo = cmulc(w[j], tw);
        const float yx = __uint_as_float(ye[j] << 16) + yo.x * (1.f / 8192.f);
        const float yy = __uint_as_float(ye[j] & 0xffff0000u) + yo.y * (1.f / 8192.f);
        const float ux = conv3l(raw0, n, m0, m1, m2, mb);
        const float uy = conv3l(raw1, n, m0, m1, m2, mb);
        const float g0 = order == 0 ? 1.f : siluf(bf2f(raw2[n]));
        const float g1 = order == 0 ? 1.f : siluf(bf2f(raw3[n]));
        o0[n] = f2bf(ux * yx * g0);
        o1[n] = f2bf(uy * yy * g1);
      }
    }
    __syncthreads();
  }
}

ITEMFN void hyena_prompt_item(const Params& p, char* smem, int c) {
  const int tid = mytid();
  cpx* buf = (cpx*)smem;
  const float* scw = p.in[I_SCW];
  const float* scb = p.in[I_SCB];
  bfr* proj = (bfr*)(p.ws + OFF_BIG);
  bfr* P0 = proj + (size_t)c * MT;
  const bfr* P1 = proj + (size_t)(1024 + c) * MT;
  const bfr* P2 = proj + (size_t)(2048 + c) * MT;
  const bfr* PG = proj + (size_t)(3072 + c) * MT;
  bfr* dst = (bfr*)(p.ws + OFF_R2) + (size_t)c * MT;
  const float* fsum = (const float*)(p.ws + OFF_FSUM);
  const float* F = (const float*)(p.ws + OFF_F256);
#pragma unroll 1
  for (int order = 0; order < 2; ++order) {
    cpx G[16];
#pragma unroll
    for (int j = 0; j < 16; ++j) { G[j].x = 0.f; G[j].y = 0.f; }
    const float inv = 1.f / (fsum[order * 1024 + c] + 1e-6f);
    G[0].x = F[((size_t)(0 * 2 + order) * 1024 + c) * 256 + tid] * inv;
    if (tid >= 1) G[15].x = F[((size_t)(1 * 2 + order) * 1024 + c) * 256 + 256 - tid] * inv;
    fft_fwd(G, buf, tid);
    const float skip = p.in[I_FSKIP][order * 1024 + c];
    const int col1 = (order + 1) * 1024 + c;
    const float a0 = scw[c], a1 = scw[3072 + c], a2 = scw[6144 + c], ab = scb[c];
    const float m0 = scw[col1], m1 = scw[3072 + col1], m2 = scw[6144 + col1], mb = scb[col1];
    const bfr* PM = order == 0 ? P1 : P2;
#pragma unroll 1
    for (int cc = 0; cc < 2; ++cc) {
      cpx zr[8], w[16];
#pragma unroll
      for (int j = 0; j < 16; ++j) {
        if ((j & 1) == 0) {
          const size_t o0 = (size_t)(16 * cc + (j >> 1)) * 256, o1 = (size_t)(16 * cc + 8 + (j >> 1)) * 256;
          if (order == 0) { zr[j >> 1].x = conv3(P0 + o0, tid, 256, a0, a1, a2, ab); zr[j >> 1].y = conv3(P0 + o1, tid, 256, a0, a1, a2, ab); }
          else { zr[j >> 1].x = bf2f(P0[o0 + tid]); zr[j >> 1].y = bf2f(P0[o1 + tid]); }
          w[j] = zr[j >> 1];
        } else { w[j].x = 0.f; w[j].y = 0.f; }
      }
      fft_fwd(w, buf, tid);
#pragma unroll
      for (int k = 0; k < 16; ++k) w[k] = cmul(w[k], G[k]);
      fft_inv(w, buf, tid);
#pragma unroll
      for (int j = 0; j < 16; j += 2) {
        const size_t o0 = (size_t)(16 * cc + (j >> 1)) * 256, o1 = (size_t)(16 * cc + 8 + (j >> 1)) * 256;
        const float yx = w[j].x * (1.f / 4096.f) + skip * zr[j >> 1].x;
        const float yy = w[j].y * (1.f / 4096.f) + skip * zr[j >> 1].y;
        const float ux = conv3(PM + o0, tid, 256, m0, m1, m2, mb);
        const float uy = conv3(PM + o1, tid, 256, m0, m1, m2, mb);
        if (order == 0) {
          P0[o0 + tid] = f2bf(ux * yx);
          P0[o1 + tid] = f2bf(uy * yy);
        } else {
          const float g0 = siluf(bf2f(PG[o0 + tid]));
          const float g1 = siluf(bf2f(PG[o1 + tid]));
          dst[o0 + tid] = f2bf(ux * yx * g0);
          dst[o1 + tid] = f2bf(uy * yy * g1);
        }
      }
    }
    __syncthreads();
  }
}


DI void p0_light(const Params& p, char* smem, int it) {
  if (it < 320) p0_fold(p, smem, it - 192);
  else if (it < 592) p0_hid(p, smem, it - 320);
  else if (it < 2768) p0_transpose(p, smem, it - 592);
  else p0_cache(p, smem, it - 2768);
}

#define XB_TMO      128
#define XB_XCNT(j)  (256  + 64 * (j))
#define XB_XSUB(j)  (1280 + 64 * (j))
#define XB_XGEN(j)  (2304 + 64 * (j))
#define XB_TOP      3328
#define XB_TOPGEN   3392
#define XCD_BAR_WORDS 3456
#define XB_SPIN_CAP (1u << 18)
#define LAS __attribute__((address_space(3)))
__device__ __forceinline__ unsigned xb_ld(unsigned* p)              { return __hip_atomic_load(p, __ATOMIC_RELAXED, __HIP_MEMORY_SCOPE_AGENT); }
__device__ __forceinline__ unsigned xb_add(unsigned* p, unsigned v) { return __hip_atomic_fetch_add(p, v, __ATOMIC_RELAXED, __HIP_MEMORY_SCOPE_AGENT); }
__device__ __forceinline__ unsigned xb_xcc_id() { return (unsigned)__builtin_amdgcn_s_getreg((3 << 11) | 20) & 0xFu; }
#define XB_SPIN(cond, bar) do { unsigned _sp = 0; while (cond) { __builtin_amdgcn_s_sleep(1); \
    if ((++_sp & 255u) == 0u) { if (xb_ld(&(bar)[XB_TMO])) break; if (_sp > XB_SPIN_CAP) { atomicAdd(&(bar)[XB_TMO], 1u); break; } } } } while (0)
struct XcdBarrier { unsigned* bar; unsigned x; volatile LAS unsigned* st; };
__device__ __forceinline__ XcdBarrier xcd_barrier_post(unsigned* bar, volatile LAS unsigned* st) {
    XcdBarrier b; b.bar = bar; b.x = xb_xcc_id(); b.st = st;
    if (threadIdx.x == 0) (void)xb_add(&bar[XB_XCNT(b.x)], 1u);
    return b;
}
__device__ __forceinline__ void xcd_barrier_complete(unsigned* bar, unsigned x, unsigned& nloc, unsigned& nx) {
    const unsigned G = gridDim.x * gridDim.y * gridDim.z;
    unsigned sum, cnt, mine, sp = 0u;
    for (;;) {
        sum = 0u; cnt = 0u; mine = 0u;
#pragma unroll
        for (unsigned j = 0; j < 16; ++j) { const unsigned c = xb_ld(&bar[XB_XCNT(j)]); sum += c; cnt += (c > 0u) ? 1u : 0u; mine = (j == x) ? c : mine; }
        if (sum == G) break;
        __builtin_amdgcn_s_sleep(1);
        if ((++sp & 255u) == 0u) { if (xb_ld(&bar[XB_TMO])) break; if (sp > XB_SPIN_CAP) { atomicAdd(&bar[XB_TMO], 1u); break; } }
    }
    nloc = mine > 0u ? mine : 1u; nx = cnt > 0u ? cnt : 1u;
}
__device__ __forceinline__ void xcd_barrier(const XcdBarrier& b) {
    asm volatile("s_waitcnt vmcnt(0)" ::: "memory");
    __syncthreads();
    if (threadIdx.x == 0) {
        unsigned* bar = b.bar;
        __builtin_amdgcn_s_waitcnt(0);
        unsigned nloc = b.st[0], nx = b.st[1];
        if (nloc == 0u) { xcd_barrier_complete(bar, b.x, nloc, nx); b.st[0] = nloc; b.st[1] = nx; }
        const unsigned old = xb_add(&bar[XB_XSUB(b.x)], 1u);
        const unsigned gen = old / nloc;
        if (old + 1u == (gen + 1u) * nloc) {
            __builtin_amdgcn_fence(__ATOMIC_RELEASE, "agent");
            asm volatile("s_waitcnt vmcnt(0)" ::: "memory");
            const unsigned og = xb_add(&bar[XB_TOP], 1u);
            const unsigned tg = og / nx;
            if (og + 1u == (tg + 1u) * nx) xb_add(&bar[XB_TOPGEN], 1u);
            else XB_SPIN(xb_ld(&bar[XB_TOPGEN]) == tg, bar);
            __builtin_amdgcn_fence(__ATOMIC_ACQUIRE, "agent");
            xb_add(&bar[XB_XGEN(b.x)], 1u);
            asm volatile("s_waitcnt vmcnt(0)" ::: "memory");
        } else {
            XB_SPIN(xb_ld(&bar[XB_XGEN(b.x)]) == gen, bar);
            __builtin_amdgcn_fence(__ATOMIC_ACQUIRE, "agent");
            asm volatile("s_waitcnt vmcnt(0)" ::: "memory");
        }
    }
    __syncthreads();
}

__global__ void __launch_bounds__(256, 2) mega(Params p, int ph_lo, int ph_hi) {
  __shared__ __attribute__((aligned(16))) char smem[49152];
  __shared__ u32x4 xb_words;
  if (threadIdx.x == 0) xb_words = u32x4{0u, 0u, 0u, 0u};
  __syncthreads();
  if (ph_lo > 4096) cg::this_grid().sync();
  const XcdBarrier xb = xcd_barrier_post((unsigned*)(p.ws + OFF_BAR), (volatile LAS unsigned*)&xb_words);
  const int bid = blockIdx.x, nb = gridDim.x;
#pragma unroll
  for (int ph = 0; ph < NPH; ++ph) {
    if (ph < ph_lo || ph >= ph_hi) continue;
    if (ph > ph_lo) {
      xcd_barrier(xb);
    }
#pragma unroll
    for (int rep = 0; rep < 1 + ((DUP_MASK >> ph) & 1); ++rep)
    switch (ph) {
      case 0:
        if (nb == 512) {
          if (bid < 192) p0_mod(p, smem, bid);
          else for (int r = 0; r < 3; ++r) p0_light(p, smem, 192 + (bid - 192) + 320 * r);
          for (int it = 192 + 960 + bid; it < 3280; it += 512) p0_light(p, smem, it);
        } else {
          for (int it = bid; it < 3280; it += nb) {
            if (it < 192) p0_mod(p, smem, it);
            else p0_light(p, smem, it);
          }
        }
        break;
      case 1:
        for (int it = bid; it < 1024 + 2560; it += nb) {
          if (it < 1024) filt_item(p, smem, 1023 - it);
          else norm_item(p, it - 1024, 0);
        }
        break;
      case 2:
        if ((nb & 7) == 0) { for (int lt = bid >> 3; lt < 40 * 12; lt += nb >> 3) { int mt, nt; tile_map<12, 4>(lt, bid & 7, mt, nt); inproj0_tile(p, smem, mt, nt); } }
        else { for (int t = bid; t < 320 * 12; t += nb) inproj0_tile(p, smem, t / 12, t % 12); }
        break;
      case 3:
        for (int k = 0; bid + k * nb < 5160; ++k) {
          const int cnt = (5160 - bid + nb - 1) / nb;
          const int it = bid + ((bid >= (nb >> 1)) ? (cnt - 1 - k) : k) * nb;
          if (it < 2048) attn_na_item(p, smem, it);
          else if (it < 2560) attn_ctx_item(p, smem, it - 2048);
          else if (it < 4640) fnet_item(p, smem, it - 2560, false);
          else fnet_item(p, smem, it - 4640, true);
        }
        break;
      case 4:
        for (int it = bid; it < 10240; it += nb) xpose_item(p, smem, it, 0);
        break;
      case 5:
        if ((nb & 7) == 0) { for (int lt = bid >> 3; lt < 40 * 8; lt += nb >> 3) { int mt, nt; tile_map<8, 8>(lt, bid & 7, mt, nt); outproj_tile(p, smem, mt, nt, 0); } }
        else { for (int t = bid; t < 320 * 8; t += nb) outproj_tile(p, smem, t >> 3, t & 7, 0); }
        break;
      case 6:
        for (int it = bid; it < 2560; it += nb) norm_item(p, it, 1);
        break;
      case 7:
        if ((nb & 7) == 0) { for (int lt = bid >> 3; lt < 40 * 16; lt += nb >> 3) { int mt, nt; tile_map<16, 8>(lt, bid & 7, mt, nt); inproj1_tile(p, smem, mt, nt); } }
        else { for (int t = bid; t < 320 * 16; t += nb) inproj1_tile(p, smem, t >> 4, t & 15); }
        break;
      case 8:
        for (int it = bid; it < 2048; it += nb) {
          if (it < 1024) hyena_sample_item(p, smem, it);
          else hyena_prompt_item(p, smem, it - 1024);
        }
        break;
      case 9:
        for (int it = bid; it < 10240; it += nb) xpose_item(p, smem, it, 1);
        break;
      case 10:
        if ((nb & 7) == 0) { for (int lt = bid >> 3; lt < 40 * 8; lt += nb >> 3) { int mt, nt; tile_map<8, 8>(lt, bid & 7, mt, nt); outproj_tile(p, smem, mt, nt, 1); } }
        else { for (int t = bid; t < 320 * 8; t += nb) outproj_tile(p, smem, t >> 3, t & 7, 1); }
        break;
    }
  }
}

extern "C" void kernel_launch(void* const* d_in, const int* in_sizes, int n_in, void* d_out, int out_size, void* d_ws,
                              size_t ws_size, hipStream_t stream) {
  Params p{};
  for (int i = 0; i < 29; ++i) p.in[i] = (const float*)d_in[i];
  p.out = (float*)d_out;
  p.ws = (char*)d_ws;
  if (ws_size < WS_NEEDED) { fprintf(stderr, "workspace too small: %zu < %zu\n", ws_size, (size_t)WS_NEEDED); return; }
  static int grid_blocks = 0;
  if (!grid_blocks) {
    int dev = 0, cus = 0, per_cu = 0;
    hipGetDevice(&dev);
    hipDeviceGetAttribute(&cus, hipDeviceAttributeMultiprocessorCount, dev);
    hipOccupancyMaxActiveBlocksPerMultiprocessor(&per_cu, mega, 256, 0);
    if (per_cu > 2) per_cu = 2;
    grid_blocks = cus * per_cu;
  }
  hipMemsetAsync((char*)d_ws + OFF_BAR, 0, 16384, stream);
#if SINGLE_LAUNCH
  int lo = 0, hi = NPH;
  void* args[] = {&p, &lo, &hi};
  hipError_t e = hipLaunchCooperativeKernel((void*)mega, dim3(grid_blocks), dim3(256), args, 0, stream);
  if (e != hipSuccess) fprintf(stderr, "cooperative launch failed: %s (grid %d)\n", hipGetErrorString(e), grid_blocks);
#else
  for (int ph = 0; ph < NPH; ++ph) mega<<<grid_blocks, 256, 0, stream>>>(p, ph, ph + 1);
#endif
}
```
